# Optimizing an MI355X kernel written in HIP

```python
import math
import jax, jax.numpy as jnp
from jax import lax
import numpy as np

D_MODEL = 1024
BATCH = 16
SEQ = 4096
DEPTH = 1

N_META = 16
S5_WIDTH = D_MODEL // 2
S5_GROUP = 16
S5_GROUPS = S5_WIDTH // S5_GROUP
S5_STATE = 64
DT_MIN = 1e-3
DT_MAX = 1e-1
M_HEADS = 4
M_DK = D_MODEL // 8
M_DV = D_MODEL // 4
M_QK_WIDTH = M_HEADS * M_DK
M_V_WIDTH = M_HEADS * M_DV
M_CHUNK = 64
CONV_WIDTH = 4
D_FF = 4 * D_MODEL
ALPHA = (2.0 * DEPTH) ** 0.25
BETA = (8.0 * DEPTH) ** -0.25
LN_EPS = 1e-5
IN_SIZES = (S5_WIDTH, M_QK_WIDTH, M_QK_WIDTH, M_V_WIDTH, M_V_WIDTH, M_HEADS, M_HEADS, D_MODEL, D_MODEL)
IN_WIDTH = sum(IN_SIZES)
F_GATE_OFFSET = S5_WIDTH + 2 * M_QK_WIDTH + 2 * M_V_WIDTH + M_HEADS

kernel_name = "hybrid_s5_mlstm_gated_block"


def _layer_norm(x, g, b):
    xf = x.astype(jnp.float32)
    mu = jnp.mean(xf, axis=-1, keepdims=True)
    var = jnp.mean(jnp.square(xf - mu), axis=-1, keepdims=True)
    y = (xf - mu) * lax.rsqrt(var + LN_EPS)
    return (y * g.astype(jnp.float32) + b.astype(jnp.float32)).astype(x.dtype)


def _head_norm(h, g):
    hf = h.astype(jnp.float32)
    mu = jnp.mean(hf, axis=-1, keepdims=True)
    var = jnp.mean(jnp.square(hf - mu), axis=-1, keepdims=True)
    return (hf - mu) * lax.rsqrt(var + LN_EPS) * g.astype(jnp.float32).reshape(M_HEADS, M_DV)


def _split_columns(p):
    parts, start = [], 0
    for size in IN_SIZES:
        parts.append(p[..., start:start + size])
        start += size
    return parts


def _causal_depthwise_conv(x, w, b):
    c = x.shape[-1]
    y = lax.conv_general_dilated(
        x, w[:, None, :].astype(x.dtype), window_strides=(1,),
        padding=((CONV_WIDTH - 1, 0),), dimension_numbers=("NWC", "WIO", "NWC"),
        feature_group_count=c)
    return y + b


def _linear_recurrence_combine(left, right):
    a_l, b_l = left
    a_r, b_r = right
    return a_l * a_r, a_r * b_l + b_r


def _s5_mixer(u, lam_re, lam_im, log_dt, b_re, b_im, c_re, c_im, d_skip):
    f32 = jnp.float32
    bsz, length, _ = u.shape
    uf = u.astype(f32).reshape(bsz, length, S5_GROUPS, S5_GROUP)
    lam = lax.complex(lam_re.astype(f32), lam_im.astype(f32))
    dt = jnp.exp(log_dt.astype(f32))[:, None]
    lam_bar = jnp.exp(lam * dt)
    b_mat = lax.complex(b_re.astype(f32), b_im.astype(f32))
    b_bar = ((lam_bar - 1.0) / lam)[..., None] * b_mat
    bu = jnp.einsum("gph,blgh->blgp", b_bar, uf.astype(jnp.complex64))
    a = jnp.broadcast_to(lam_bar, (1, length, S5_GROUPS, S5_STATE))
    _, state = lax.associative_scan(_linear_recurrence_combine, (a, bu), axis=1)
    c_mat = lax.complex(c_re.astype(f32), c_im.astype(f32))
    y = jnp.real(jnp.einsum("ghp,blgp->blgh", c_mat, state))
    y = y + d_skip.astype(f32).reshape(S5_GROUPS, S5_GROUP) * uf
    return y.reshape(bsz, length, S5_WIDTH)


def _mlstm_mixer(q, k, v, i_pre, f_pre):
    f32 = jnp.float32
    bsz, length = q.shape[:2]
    n_pad = M_CHUNK - N_META
    n_chunks = (length + n_pad) // M_CHUNK

    def to_chunks(t, fill):
        t = t.astype(f32)
        t = jnp.pad(t, ((0, 0), (n_pad, 0)) + ((0, 0),) * (t.ndim - 2), constant_values=fill)
        t = t.reshape((bsz, n_chunks, M_CHUNK) + t.shape[2:])
        return jnp.moveaxis(t, (1, 3), (0, 2))

    qc = to_chunks(q, 0.0)
    kc = to_chunks(k * (M_DK ** -0.5), 0.0)
    vc = to_chunks(v, 0.0)
    log_i = to_chunks(i_pre, -jnp.inf)
    log_f = to_chunks(jax.nn.log_sigmoid(f_pre.astype(f32)), 0.0)
    causal = jnp.tril(jnp.ones((M_CHUNK, M_CHUNK), dtype=bool))

    def chunk_step(carry, inp):
        c_st, n_st, m_st = carry
        q_c, k_c, v_c, li_c, lf_c = inp
        b = jnp.cumsum(lf_c, axis=-1)
        d_mat = jnp.where(causal, b[..., :, None] - b[..., None, :] + li_c[..., None, :], -jnp.inf)
        m_inter = b + m_st[..., None]
        m_row = jnp.maximum(m_inter, jnp.max(d_mat, axis=-1))
        w_intra = jnp.exp(d_mat - m_row[..., None])
        w_inter = jnp.exp(m_inter - m_row)
        s = jnp.einsum("bhsd,bhjd->bhsj", q_c, k_c) * w_intra
        num = (jnp.einsum("bhsj,bhje->bhse", s, v_c)
               + w_inter[..., None] * jnp.einsum("bhsd,bhde->bhse", q_c, c_st))
        den = jnp.sum(s, axis=-1) + w_inter * jnp.einsum("bhsd,bhd->bhs", q_c, n_st)
        h_c = num / jnp.maximum(jnp.abs(den), jnp.exp(-m_row))[..., None]
        b_last = b[..., -1]
        g_log = b_last[..., None] - b + li_c
        m_new = jnp.maximum(b_last + m_st, jnp.max(g_log, axis=-1))
        w_k = jnp.exp(g_log - m_new[..., None])
        decay = jnp.exp(b_last + m_st - m_new)
        c_new = decay[..., None, None] * c_st + jnp.einsum("bhj,bhjd,bhje->bhde", w_k, k_c, v_c)
        n_new = decay[..., None] * n_st + jnp.einsum("bhj,bhjd->bhd", w_k, k_c)
        return (c_new, n_new, m_new), h_c

    init = (jnp.zeros((bsz, M_HEADS, M_DK, M_DV), f32),
            jnp.zeros((bsz, M_HEADS, M_DK), f32),
            jnp.zeros((bsz, M_HEADS), f32))
    _, h = lax.scan(chunk_step, init, (qc, kc, vc, log_i, log_f))
    h = jnp.moveaxis(h, (0, 2), (1, 3)).reshape(bsz, n_chunks * M_CHUNK, M_HEADS, M_DV)
    return h[:, n_pad:]


def setup_inputs(seed: int = 0) -> dict:
    key = jax.random.key(seed)
    ks = jax.random.split(key, 27)
    f32 = jnp.float32

    def nrm(k, shape, scale):
        return scale * jax.random.normal(k, shape, f32)

    b_in = nrm(ks[5], (DEPTH, IN_WIDTH), 0.02)
    b_in = b_in.at[:, F_GATE_OFFSET:F_GATE_OFFSET + M_HEADS].add(jnp.linspace(3.0, 6.0, M_HEADS))
    s5_lambda_re = -0.5 + nrm(ks[8], (DEPTH, S5_GROUPS, S5_STATE), 0.01)
    s5_lambda_im = jnp.pi * jnp.arange(S5_STATE, dtype=f32) + nrm(ks[9], (DEPTH, S5_GROUPS, S5_STATE), 0.01)
    s5_log_dt = jax.random.uniform(ks[10], (DEPTH, S5_GROUPS), f32, math.log(DT_MIN), math.log(DT_MAX))
    return {
        "x": nrm(ks[0], (BATCH, SEQ, D_MODEL), 1.0),
        "meta_tokens": nrm(ks[1], (N_META, D_MODEL), 1.0),
        "ln0_g": 1.0 + nrm(ks[2], (D_MODEL,), 0.05),
        "ln0_b": nrm(ks[3], (D_MODEL,), 0.02),
        "w_in": nrm(ks[4], (DEPTH, D_MODEL, IN_WIDTH), D_MODEL ** -0.5),
        "b_in": b_in,
        "qk_conv_w": nrm(ks[6], (DEPTH, CONV_WIDTH, 2 * M_QK_WIDTH), CONV_WIDTH ** -0.5),
        "qk_conv_b": nrm(ks[7], (DEPTH, 2 * M_QK_WIDTH), 0.02),
        "s5_lambda_re": s5_lambda_re,
        "s5_lambda_im": s5_lambda_im,
        "s5_log_dt": s5_log_dt,
        "s5_b_re": nrm(ks[11], (DEPTH, S5_GROUPS, S5_STATE, S5_GROUP), (2.0 * S5_GROUP) ** -0.5),
        "s5_b_im": nrm(ks[12], (DEPTH, S5_GROUPS, S5_STATE, S5_GROUP), (2.0 * S5_GROUP) ** -0.5),
        "s5_c_re": nrm(ks[13], (DEPTH, S5_GROUPS, S5_GROUP, S5_STATE), S5_STATE ** -0.5),
        "s5_c_im": nrm(ks[14], (DEPTH, S5_GROUPS, S5_GROUP, S5_STATE), S5_STATE ** -0.5),
        "s5_d": nrm(ks[15], (DEPTH, S5_WIDTH), 1.0),
        "s5_w_glu": nrm(ks[16], (DEPTH, S5_WIDTH, 2 * D_MODEL), S5_WIDTH ** -0.5),
        "m_norm_g": 1.0 + nrm(ks[17], (DEPTH, M_V_WIDTH), 0.05),
        "m_w_out": nrm(ks[18], (DEPTH, M_V_WIDTH, D_MODEL), M_V_WIDTH ** -0.5),
        "w_o": nrm(ks[19], (DEPTH, D_MODEL, D_MODEL), BETA * D_MODEL ** -0.5),
        "ln1_g": 1.0 + nrm(ks[20], (DEPTH, D_MODEL), 0.05),
        "ln1_b": nrm(ks[21], (DEPTH, D_MODEL), 0.02),
        "w_up": nrm(ks[22], (DEPTH, D_MODEL, D_FF), D_MODEL ** -0.5),
        "b_up": nrm(ks[23], (DEPTH, D_FF), 0.02),
        "w_down": nrm(ks[24], (DEPTH, D_FF, D_MODEL), BETA * D_FF ** -0.5),
        "ln2_g": 1.0 + nrm(ks[25], (DEPTH, D_MODEL), 0.05),
        "ln2_b": nrm(ks[26], (DEPTH, D_MODEL), 0.02),
    }


def reference(x, meta_tokens, ln0_g, ln0_b, w_in, b_in, qk_conv_w, qk_conv_b,
              s5_lambda_re, s5_lambda_im, s5_log_dt, s5_b_re, s5_b_im, s5_c_re, s5_c_im,
              s5_d, s5_w_glu, m_norm_g, m_w_out, w_o, ln1_g, ln1_b, w_up, b_up, w_down,
              ln2_g, ln2_b):
    bsz = x.shape[0]
    meta = jnp.broadcast_to(meta_tokens[None].astype(x.dtype), (bsz, N_META, D_MODEL))
    h = _layer_norm(jnp.concatenate([meta, x], axis=1), ln0_g, ln0_b)
    length = h.shape[1]
    for layer in range(DEPTH):
        p = h @ w_in[layer] + b_in[layer]
        u_s5, q, k, v, o_pre, i_pre, f_pre, g_s5, g_m = _split_columns(p)
        y_s5 = _s5_mixer(u_s5, s5_lambda_re[layer], s5_lambda_im[layer], s5_log_dt[layer],
                         s5_b_re[layer], s5_b_im[layer], s5_c_re[layer], s5_c_im[layer], s5_d[layer])
        z = jax.nn.gelu(y_s5).astype(h.dtype) @ s5_w_glu[layer]
        y_s5 = z[..., :D_MODEL] * jax.nn.sigmoid(z[..., D_MODEL:])
        qk = jax.nn.silu(_causal_depthwise_conv(jnp.concatenate([q, k], axis=-1),
                                                qk_conv_w[layer], qk_conv_b[layer]))
        q_h = qk[..., :M_QK_WIDTH].reshape(bsz, length, M_HEADS, M_DK)
        k_h = qk[..., M_QK_WIDTH:].reshape(bsz, length, M_HEADS, M_DK)
        v_h = v.reshape(bsz, length, M_HEADS, M_DV)
        hm = _mlstm_mixer(q_h, k_h, v_h, i_pre, f_pre)
        hm = _head_norm(hm, m_norm_g[layer]).reshape(bsz, length, M_V_WIDTH).astype(h.dtype)
        y_m = (jax.nn.sigmoid(o_pre) * hm) @ m_w_out[layer]
        mix = jax.nn.sigmoid(g_s5) * y_s5 + jax.nn.sigmoid(g_m) * y_m
        h = _layer_norm(ALPHA * h + mix @ w_o[layer], ln1_g[layer], ln1_b[layer])
        ff = jnp.square(jax.nn.relu(h @ w_up[layer] + b_up[layer])) @ w_down[layer]
        h = _layer_norm(ALPHA * h + ff, ln2_g[layer], ln2_b[layer])
    return h[:, N_META:]
```

```cpp
#include <hip/hip_runtime.h>
#include <cstdio>
#include <cstdint>
namespace pg8 {
#define PG8_LAS __attribute__((address_space(3)))
typedef unsigned short bf16_t;
typedef short bf16x8 __attribute__((ext_vector_type(8)));
typedef float f32x4 __attribute__((ext_vector_type(4)));
typedef unsigned u32x4 __attribute__((ext_vector_type(4)));
constexpr int BM = 256, BK = 64, HALF = 128, HTB = HALF * BK * 2  , STAGE_BYTES = 8 * HTB, NXCD = 8, WGM = 8;

__host__ __device__ __forceinline__ int lds_byte(int r, int c) { const int st = (r >> 4) * 2 + (c >> 5), rr = r & 15, cc = c & 31, ob = rr * 64 + cc * 2; return st * 1024 + (ob ^ (((ob >> 9) & 1) << 5)); }
__host__ __device__ __forceinline__ void stage_rc(int b, int& R, int& C) { const int st = b / 1024, sb = b % 1024, swz = sb ^ (((sb >> 9) & 1) << 5); R = (st >> 1) * 16 + swz / 64; C = (st & 1) * 32 + (swz % 64) / 2; }
__host__ __device__ __forceinline__ int perm32(int rho) { const int n = rho >> 4, i = rho & 15; return 8 * (i >> 2) + 4 * n + (i & 3); }

struct Unit { int pm, pn; };
struct Gemm { const bf16_t* A; const bf16_t* Bt; int M, N, K; };

struct StaticOrder {
    int nM, nN, nwg, G, c;
    __host__ __device__ void init(int M, int N, int G_, int c_) { nM = M / BM; nN = N / BM; nwg = nM * nN; G = G_; c = c_; }
    __host__ __device__ bool next(int i, Unit& u) const {
        const long L = (long)i * G + c; if (L >= nwg) return false;
        int wgid = (int)L; { const int q = nwg / NXCD, r = nwg % NXCD, xcd = wgid % NXCD, off = wgid / NXCD; wgid = (xcd < r ? xcd * (q + 1) : r * (q + 1) + (xcd - r) * q) + off; }
        const int nig = WGM * nN, gid = wgid / nig, fm = gid * WGM, gsz = (nM - fm) < WGM ? (nM - fm) : WGM;
        u.pm = fm + ((wgid % nig) % gsz); u.pn = (wgid % nig) / gsz; return true;
    }
    __device__ __forceinline__ void a_ready(const Unit&) const {}
    __device__ __forceinline__ void done(const Unit&) const {}
};

__device__ __forceinline__ unsigned cvt_pk_bf16(float lo, float hi) { unsigned r; asm volatile("v_cvt_pk_bf16_f32 %0, %1, %2" : "=v"(r) : "v"(lo), "v"(hi)); return r; }
typedef float f32x2 __attribute__((ext_vector_type(2)));
__device__ __forceinline__ float sigm(float x) { return __builtin_amdgcn_rcpf(1.0f + __builtin_amdgcn_exp2f(-1.4426950408889634f * x)); }
__device__ __forceinline__ f32x4 bf4f(unsigned lo, unsigned hi) { return (f32x4){__uint_as_float(lo << 16), __uint_as_float(lo & 0xffff0000u), __uint_as_float(hi << 16), __uint_as_float(hi & 0xffff0000u)}; }
typedef unsigned u32x2 __attribute__((ext_vector_type(2)));

struct EpiIn {
    static constexpr bool PERM = true, AFTER_DRAIN = false;
    bf16_t* P; int ldc; const float* bias; int sig_from;
    __device__ __forceinline__ void operator()(const f32x4 (&acc)[2][2][4][2], const Unit& u, int wr, int wc, int fr, int fq) const {
        const int row0 = u.pm * BM + wr * 64 + fr, col0 = u.pn * BM + wc * 32 + 8 * fq; const bool sg = u.pn >= sig_from;
        f32x4 bv[2][2];
#pragma unroll
        for (int bj = 0; bj < 2; ++bj)
#pragma unroll
            for (int n = 0; n < 2; ++n) bv[bj][n] = *(const f32x4*)(bias + col0 + bj * HALF + 4 * n);
#pragma unroll
        for (int ai = 0; ai < 2; ++ai)
#pragma unroll
            for (int m = 0; m < 4; ++m) { bf16_t* rowp = P + (size_t)(row0 + ai * HALF + m * 16) * ldc + col0;
#pragma unroll
                for (int bj = 0; bj < 2; ++bj) { f32x4 v0 = acc[ai][bj][m][0] + bv[bj][0], v1 = acc[ai][bj][m][1] + bv[bj][1];
                    if (sg) {
#pragma unroll
                        for (int j = 0; j < 4; ++j) { v0[j] = sigm(v0[j]); v1[j] = sigm(v1[j]); } }
                    u32x4 w; w.x = cvt_pk_bf16(v0[0], v0[1]); w.y = cvt_pk_bf16(v0[2], v0[3]); w.z = cvt_pk_bf16(v1[0], v1[1]); w.w = cvt_pk_bf16(v1[2], v1[3]);
                    *(u32x4*)(rowp + bj * HALF) = w; } }
    }
};
struct EpiGlu {
    static constexpr bool PERM = true, AFTER_DRAIN = false;
    const bf16_t* SG; int ldsg; bf16_t* O; int ldo;
    __device__ __forceinline__ void operator()(const f32x4 (&acc)[2][2][4][2], const Unit& u, int wr, int wc, int fr, int fq) const {
        const int row0 = u.pm * BM + wr * 64 + fr, col = u.pn * HALF + wc * 32 + 8 * fq;
#pragma unroll
        for (int ai = 0; ai < 2; ++ai)
#pragma unroll
            for (int m = 0; m < 4; ++m) { const size_t r = (size_t)(row0 + ai * HALF + m * 16);
                const u32x4 s = *(const u32x4*)(SG + r * ldsg + col); const f32x4 s0 = bf4f(s.x, s.y), s1 = bf4f(s.z, s.w);
                f32x4 o0, o1;
#pragma unroll
                for (int j = 0; j < 4; ++j) { o0[j] = s0[j] * acc[ai][0][m][0][j] * sigm(acc[ai][1][m][0][j]); o1[j] = s1[j] * acc[ai][0][m][1][j] * sigm(acc[ai][1][m][1][j]); }
                u32x4 w; w.x = cvt_pk_bf16(o0[0], o0[1]); w.y = cvt_pk_bf16(o0[2], o0[3]); w.z = cvt_pk_bf16(o1[0], o1[1]); w.w = cvt_pk_bf16(o1[2], o1[3]);
                *(u32x4*)(O + r * ldo + col) = w; }
    }
};
struct EpiMo {
    static constexpr bool PERM = true, AFTER_DRAIN = false;
    const bf16_t* SG; int ldsg; bf16_t* O; int ldo;
    __device__ __forceinline__ void operator()(const f32x4 (&acc)[2][2][4][2], const Unit& u, int wr, int wc, int fr, int fq) const {
        const int row0 = u.pm * BM + wr * 64 + fr, col0 = u.pn * BM + wc * 32 + 8 * fq;
#pragma unroll
        for (int ai = 0; ai < 2; ++ai)
#pragma unroll
            for (int m = 0; m < 4; ++m) { const size_t r = (size_t)(row0 + ai * HALF + m * 16);
#pragma unroll
                for (int bj = 0; bj < 2; ++bj) { const int col = col0 + bj * HALF;
                    const u32x4 s = *(const u32x4*)(SG + r * ldsg + col), x = *(const u32x4*)(O + r * ldo + col);
                    const f32x4 o0 = bf4f(x.x, x.y) + bf4f(s.x, s.y) * acc[ai][bj][m][0], o1 = bf4f(x.z, x.w) + bf4f(s.z, s.w) * acc[ai][bj][m][1];
                    u32x4 w; w.x = cvt_pk_bf16(o0[0], o0[1]); w.y = cvt_pk_bf16(o0[2], o0[3]); w.z = cvt_pk_bf16(o1[0], o1[1]); w.w = cvt_pk_bf16(o1[2], o1[3]);
                    *(u32x4*)(O + r * ldo + col) = w; } }
    }
};
struct EpiRes {
    static constexpr bool PERM = false, AFTER_DRAIN = false;
    const bf16_t* R; float* V; int ldc; float alpha;
    __device__ __forceinline__ void operator()(const f32x4 (&acc)[2][2][4][2], const Unit& u, int wr, int wc, int fr, int fq) const {
        const int row0 = u.pm * BM + wr * 64 + fr, col0 = u.pn * BM + wc * 32 + 4 * fq;
#pragma unroll
        for (int ai = 0; ai < 2; ++ai)
#pragma unroll
            for (int m = 0; m < 4; ++m) { const size_t off = (size_t)(row0 + ai * HALF + m * 16) * ldc + col0;
#pragma unroll
                for (int bj = 0; bj < 2; ++bj)
#pragma unroll
                    for (int n = 0; n < 2; ++n) { const u32x2 x = *(const u32x2*)(R + off + bj * HALF + n * 16);
                        *(f32x4*)(V + off + bj * HALF + n * 16) = bf4f(x.x, x.y) * alpha + acc[ai][bj][m][n]; } }
    }
};
struct EpiUp {
    static constexpr bool PERM = true, AFTER_DRAIN = false;
    bf16_t* O; int ldc; const float* bias;
    __device__ __forceinline__ void operator()(const f32x4 (&acc)[2][2][4][2], const Unit& u, int wr, int wc, int fr, int fq) const {
        const int row0 = u.pm * BM + wr * 64 + fr, col0 = u.pn * BM + wc * 32 + 8 * fq;
        f32x4 bv[2][2];
#pragma unroll
        for (int bj = 0; bj < 2; ++bj)
#pragma unroll
            for (int n = 0; n < 2; ++n) bv[bj][n] = *(const f32x4*)(bias + col0 + bj * HALF + 4 * n);
#pragma unroll
        for (int ai = 0; ai < 2; ++ai)
#pragma unroll
            for (int m = 0; m < 4; ++m) { bf16_t* rowp = O + (size_t)(row0 + ai * HALF + m * 16) * ldc + col0;
#pragma unroll
                for (int bj = 0; bj < 2; ++bj) { f32x4 v0 = acc[ai][bj][m][0] + bv[bj][0], v1 = acc[ai][bj][m][1] + bv[bj][1];
#pragma unroll
                    for (int j = 0; j < 4; ++j) { const float a = fmaxf(v0[j], 0.f), b = fmaxf(v1[j], 0.f); v0[j] = a * a; v1[j] = b * b; }
                    u32x4 w; w.x = cvt_pk_bf16(v0[0], v0[1]); w.y = cvt_pk_bf16(v0[2], v0[3]); w.z = cvt_pk_bf16(v1[0], v1[1]); w.w = cvt_pk_bf16(v1[2], v1[3]);
                    *(u32x4*)(rowp + bj * HALF) = w; } }
    }
};
template <class Epi, class Sched, bool ALIGN_EPI = false, bool SP2 = false>
__device__ __forceinline__ void gemm_phase(PG8_LAS unsigned char* lds, const Gemm g, const Sched& S, const Epi& E) {
    const int tid = threadIdx.x, wid = __builtin_amdgcn_readfirstlane(tid >> 6), lane = tid & 63, wr = wid >> 2, wc = wid & 3, fr = lane & 15, fq = lane >> 4;
    const int K = g.K, nt = K / BK;
    unsigned voffA[2], voffB[2];
#pragma unroll
    for (int i = 0; i < 2; ++i) { int R, C; stage_rc(tid * 16 + i * 8192, R, C); const int Rb = Epi::PERM ? ((R & ~31) + perm32(R & 31)) : R;
        voffA[i] = (unsigned)(R * K + C) * 2u; voffB[i] = (unsigned)(Rb * K + C) * 2u; }
    const size_t kstep = (size_t)(BK * 2);
    const size_t hstep = (size_t)HALF * K * 2;
    const size_t tstep = 2 * hstep;
    const unsigned ldsw = (unsigned)wid * 1024u;
    const int aoff = lds_byte(wr * 64 + fr, fq * 8), boff = lds_byte(wc * 32 + fr, fq * 8);
#define PG8_SA(b, h) (((b) * 2 + (h)) * HTB)
#define PG8_SB(b, h) ((4 + (b) * 2 + (h)) * HTB)
#define PG8_STAGE(bufoff, gbase, voff) do { _Pragma("unroll") for (int _i = 0; _i < 2; ++_i) \
        __builtin_amdgcn_global_load_lds((const unsigned*)((const char*)(gbase) + (voff)[_i]), (PG8_LAS unsigned*)(lds + (bufoff) + ldsw + _i * 8192), 16, 0, 0); } while (0)
#define PG8_LDA(dst, b, h) do { _Pragma("unroll") for (int m = 0; m < 4; ++m) _Pragma("unroll") for (int k = 0; k < 2; ++k) dst[m][k] = *(const PG8_LAS bf16x8*)(lds + PG8_SA(b, h) + aoff + m * 2048 + k * 1024); } while (0)
#define PG8_LDB(dst, b, h) do { _Pragma("unroll") for (int n = 0; n < 2; ++n) _Pragma("unroll") for (int k = 0; k < 2; ++k) dst[n][k] = *(const PG8_LAS bf16x8*)(lds + PG8_SB(b, h) + boff + n * 2048 + k * 1024); } while (0)
#define PG8_MMA(ai, bj, At, Bt) do { __builtin_amdgcn_s_setprio(1); _Pragma("unroll") for (int m = 0; m < 4; ++m) _Pragma("unroll") for (int n = 0; n < 2; ++n) _Pragma("unroll") for (int k = 0; k < 2; ++k) \
        acc[ai][bj][m][n] = __builtin_amdgcn_mfma_f32_16x16x32_bf16(Bt[n][k], At[m][k], acc[ai][bj][m][n], 0, 0, 0); __builtin_amdgcn_s_setprio(0); } while (0)
#define PG8_WAIT_V(n) asm volatile("s_waitcnt vmcnt(" #n ")" ::: "memory")
#define PG8_WAIT_L(n) asm volatile("s_waitcnt lgkmcnt(" #n ")" ::: "memory")
#define PG8_BAR __builtin_amdgcn_s_barrier()
#define PG8_SCHED __builtin_amdgcn_sched_barrier(0)
    Unit cur, nxt; int ui = 0;
    if (!S.next(0, cur)) return;
    f32x4 acc[2][2][4][2];
#pragma unroll
    for (int a = 0; a < 2; ++a)
#pragma unroll
        for (int b = 0; b < 2; ++b)
#pragma unroll
            for (int m = 0; m < 4; ++m)
#pragma unroll
                for (int n = 0; n < 2; ++n) acc[a][b][m][n] = (f32x4){0.f, 0.f, 0.f, 0.f};
    bf16x8 At[4][2], B0[2][2], B1[2][2];
    const char* cA = (const char*)g.A + (size_t)cur.pm * tstep; const char* cB = (const char*)g.Bt + (size_t)cur.pn * tstep;
    S.a_ready(cur);
    if constexpr (SP2) {
        PG8_STAGE(PG8_SB(0, 0), cB, voffB); PG8_STAGE(PG8_SB(0, 1), cB + hstep, voffB); PG8_STAGE(PG8_SA(0, 0), cA, voffA); PG8_STAGE(PG8_SA(0, 1), cA + hstep, voffA);
        if (wr == 1) PG8_BAR;
        PG8_WAIT_V(2); PG8_BAR;
        PG8_STAGE(PG8_SB(1, 0), cB + kstep, voffB); PG8_STAGE(PG8_SA(1, 0), cA + kstep, voffA); PG8_STAGE(PG8_SB(1, 1), cB + hstep + kstep, voffB);
        PG8_WAIT_V(6); PG8_BAR;
    } else {
        PG8_STAGE(PG8_SB(0, 0), cB, voffB); PG8_STAGE(PG8_SA(0, 0), cA, voffA); PG8_STAGE(PG8_SB(0, 1), cB + hstep, voffB); PG8_STAGE(PG8_SA(0, 1), cA + hstep, voffA);
        if (wr == 1) PG8_BAR;
        PG8_WAIT_V(4); PG8_BAR;
        PG8_STAGE(PG8_SB(1, 0), cB + kstep, voffB); PG8_STAGE(PG8_SA(1, 0), cA + kstep, voffA); PG8_STAGE(PG8_SB(1, 1), cB + hstep + kstep, voffB);
        PG8_WAIT_V(6); PG8_BAR;
    }
    for (;;) {
        const bool has_next = S.next(ui + 1, nxt);
        const char* nA = has_next ? (const char*)g.A + (size_t)nxt.pm * tstep : cA; const char* nB = has_next ? (const char*)g.Bt + (size_t)nxt.pn * tstep : cB;
        for (int t = 0; t < nt; t += 2) {
            const bool last = (t == nt - 2);
            const char* a1 = cA + (size_t)(t + 1) * kstep;
            const char* a2 = last ? nA : cA + (size_t)(t + 2) * kstep; const char* b2 = last ? nB : cB + (size_t)(t + 2) * kstep;
            const char* a3 = a2 + kstep; const char* b3 = b2 + kstep;
            if (last && has_next) S.a_ready(nxt);
            if constexpr (SP2) {
            PG8_LDB(B0, 0, 0); PG8_LDB(B1, 0, 1); PG8_SCHED; PG8_LDA(At, 0, 0); PG8_STAGE(PG8_SA(1, 1), a1 + hstep, voffA);
            PG8_WAIT_V(8); PG8_WAIT_L(0); PG8_BAR; PG8_MMA(0, 0, At, B0); PG8_MMA(0, 1, At, B1); PG8_BAR; PG8_SCHED;
            PG8_LDA(At, 0, 1); PG8_STAGE(PG8_SB(0, 0), b2, voffB); PG8_STAGE(PG8_SB(0, 1), b2 + hstep, voffB); PG8_STAGE(PG8_SA(0, 0), a2, voffA);
            PG8_WAIT_V(8); PG8_WAIT_L(0); PG8_BAR; PG8_MMA(1, 0, At, B0); PG8_MMA(1, 1, At, B1); PG8_BAR; PG8_SCHED;
            PG8_LDB(B0, 1, 0); PG8_LDB(B1, 1, 1); PG8_SCHED; PG8_LDA(At, 1, 0); PG8_STAGE(PG8_SA(0, 1), a2 + hstep, voffA);
            PG8_WAIT_V(8); PG8_WAIT_L(0); PG8_BAR; PG8_MMA(0, 0, At, B0); PG8_MMA(0, 1, At, B1); PG8_BAR; PG8_SCHED;
            PG8_LDA(At, 1, 1); PG8_STAGE(PG8_SB(1, 0), b3, voffB); PG8_STAGE(PG8_SB(1, 1), b3 + hstep, voffB); PG8_STAGE(PG8_SA(1, 0), a3, voffA);
            PG8_WAIT_V(8); PG8_WAIT_L(0); PG8_BAR; PG8_MMA(1, 0, At, B0); PG8_MMA(1, 1, At, B1); PG8_BAR; PG8_SCHED;
            } else {
            PG8_LDB(B0, 0, 0); PG8_SCHED; PG8_LDA(At, 0, 0); PG8_STAGE(PG8_SA(1, 1), a1 + hstep, voffA);
            PG8_WAIT_L(8); PG8_BAR; PG8_WAIT_L(0); PG8_MMA(0, 0, At, B0); PG8_BAR; PG8_SCHED;
            PG8_LDB(B1, 0, 1); PG8_STAGE(PG8_SB(0, 0), b2, voffB);
            PG8_BAR; PG8_WAIT_L(0); PG8_MMA(0, 1, At, B1); PG8_BAR;
            PG8_LDA(At, 0, 1); PG8_STAGE(PG8_SA(0, 0), a2, voffA);
            PG8_BAR; PG8_WAIT_L(0); PG8_MMA(1, 0, At, B0); PG8_BAR; PG8_SCHED;
            PG8_STAGE(PG8_SB(0, 1), b2 + hstep, voffB);
            PG8_WAIT_V(6); PG8_BAR; PG8_MMA(1, 1, At, B1); PG8_BAR;
            PG8_LDB(B0, 1, 0); PG8_SCHED; PG8_LDA(At, 1, 0); PG8_STAGE(PG8_SA(0, 1), a2 + hstep, voffA);
            PG8_WAIT_L(8); PG8_BAR; PG8_WAIT_L(0); PG8_MMA(0, 0, At, B0); PG8_BAR; PG8_SCHED;
            PG8_LDB(B1, 1, 1); PG8_STAGE(PG8_SB(1, 0), b3, voffB);
            PG8_BAR; PG8_WAIT_L(0); PG8_MMA(0, 1, At, B1); PG8_BAR;
            PG8_LDA(At, 1, 1); PG8_STAGE(PG8_SA(1, 0), a3, voffA);
            PG8_BAR; PG8_WAIT_L(0); PG8_MMA(1, 0, At, B0); PG8_BAR; PG8_SCHED;
            PG8_STAGE(PG8_SB(1, 1), b3 + hstep, voffB);
            PG8_WAIT_V(6); PG8_BAR; PG8_MMA(1, 1, At, B1); PG8_BAR;
            }
        }
        if constexpr (ALIGN_EPI) { if (wr == 0) PG8_BAR; }
        if constexpr (!Epi::AFTER_DRAIN) { E(acc, cur, wr, wc, fr, fq); S.done(cur); }
        if (!has_next) break;
#pragma unroll
        for (int a = 0; a < 2; ++a)
#pragma unroll
            for (int b = 0; b < 2; ++b)
#pragma unroll
                for (int m = 0; m < 4; ++m)
#pragma unroll
                    for (int n = 0; n < 2; ++n) acc[a][b][m][n] = (f32x4){0.f, 0.f, 0.f, 0.f};
        cur = nxt; cA = nA; cB = nB; ++ui;
        if constexpr (ALIGN_EPI) { if (wr == 1) PG8_BAR; }
    }
    PG8_WAIT_V(0);
    if constexpr (!ALIGN_EPI) { if (wr == 0) PG8_BAR; }
    PG8_BAR;
    if constexpr (Epi::AFTER_DRAIN) { E.fused(acc, cur, wr, wc, fr, fq, lds, wid, lane); S.done(cur); }
#undef PG8_SA
#undef PG8_SB
#undef PG8_STAGE
#undef PG8_LDA
#undef PG8_LDB
#undef PG8_MMA
#undef PG8_WAIT_V
#undef PG8_WAIT_L
#undef PG8_BAR
#undef PG8_SCHED
}
}
#define LAS __attribute__((address_space(3)))
typedef unsigned short bf16;
typedef unsigned v4u __attribute__((ext_vector_type(4)));
typedef unsigned v2u __attribute__((ext_vector_type(2)));
typedef float f32x4 __attribute__((ext_vector_type(4)));
typedef float f32x2 __attribute__((ext_vector_type(2)));
typedef short bf16x8 __attribute__((ext_vector_type(8)));
constexpr int NWAVES = 8, NTHR = 512;
constexpr int BATCH = 16, SEQ = 4096, D = 1024, NMETA = 16, FF = 4096;
constexpr int MR = BATCH * SEQ;
constexpr int META0 = MR;
constexpr int MT = MR + 256;
constexpr int NROWS_LN0 = MR + NMETA;
constexpr int INW = 5640, NIN = 5632;
constexpr int PU = 0, PQ = 512, PK = 1024, PV = 1536, PO = 2560, PGS = 3584, PGM = 4608;
constexpr int IFCOL = 3584;
constexpr int S5G = 32, S5P = 64, S5H = 16, S5W = 512;
constexpr int NCH = 64;
constexpr int MH = 4, DK = 128, DV = 256;
constexpr float LN_EPS = 1e-5f;
constexpr float ALPHA = 1.189207115002721f;

constexpr size_t MiB = 1u << 20;
constexpr size_t WS_CTL = 0, CTL_ZERO_BYTES = 1 * MiB;
constexpr size_t WS_WIN = 2 * MiB, WS_WGLU = 13 * MiB, WS_WMO = 15 * MiB, WS_WO = 17 * MiB, WS_WUP = 19 * MiB, WS_WDN = 27 * MiB;
constexpr size_t WS_SMALL = 35 * MiB;
constexpr size_t WS_KTAB = 36 * MiB;
constexpr size_t WS_M1 = 37 * MiB;
constexpr size_t WS_M2 = 45 * MiB;
constexpr size_t WS_S = 53 * MiB;
constexpr size_t WS_X = 69 * MiB;
constexpr size_t WS_IF = 77 * MiB;
constexpr size_t WS_H0 = 80 * MiB;
constexpr size_t WS_P = 209 * MiB;
constexpr size_t WS_G = 916 * MiB;
constexpr size_t WS_END = 980 * MiB;
constexpr size_t WS_H1 = WS_P;
constexpr size_t WS_V1 = WS_P + 128 * MiB;
constexpr size_t WS_HFF = WS_P + 128 * MiB;
static_assert(WS_H0 + (size_t)MT * D * 2 <= WS_P && WS_P + (size_t)MT * NIN * 2 <= WS_G && WS_G + (size_t)MR * 512 * 2 <= WS_END, "ws map");
static_assert(WS_HFF + (size_t)MR * FF * 2 <= WS_G && WS_IF + (size_t)MT * 8 * 4 <= WS_H0, "ws map 2");
constexpr int LDS_BYTES = 163840;
constexpr int RING_BYTES = 131072;

__device__ __forceinline__ unsigned f2bf(float f) { unsigned u = __builtin_bit_cast(unsigned, f); return (u + 0x7fffu + ((u >> 16) & 1u)) >> 16; }
__device__ __forceinline__ unsigned pk2(float lo, float hi) { return pg8::cvt_pk_bf16(lo, hi); }
__device__ __forceinline__ float bf2f(unsigned short b) { return __uint_as_float(((unsigned)b) << 16); }
__device__ __forceinline__ float bflo(unsigned w) { return __uint_as_float(w << 16); }
__device__ __forceinline__ float bfhi(unsigned w) { return __uint_as_float(w & 0xffff0000u); }
__device__ __forceinline__ float wave_sum(float v) {
#pragma unroll
    for (int o = 1; o < 64; o <<= 1) v += __shfl_xor(v, o);
    return v;
}
__device__ __forceinline__ float sigmf(float x) { return pg8::sigm(x); }
__device__ __forceinline__ float gelu_tanh(float y) { const float z = 0.7978845608028654f * (y + 0.044715f * y * y * y); const float e = __expf(2.f * z); const float th = 1.f - 2.f * __builtin_amdgcn_rcpf(1.f + e); return 0.5f * y * (1.f + th); }
__device__ __forceinline__ float log_sigmoid(float x) { return x >= 0.f ? -log1pf(__expf(-x)) : x - log1pf(__expf(x)); }

struct Args { const float* in[27]; float* out; unsigned char* ws; int ph_lo, ph_hi; };

__device__ __forceinline__ void transpose_item(const float* W, int K, int N, bf16* WT, int dst_r0, int src_c0, int k0, LAS float* scr, int lane) {
#pragma unroll 8
    for (int i = 0; i < 32; ++i) { const int kk = 2 * i + (lane >> 5); scr[kk * 33 + (lane & 31)] = W[(size_t)(k0 + kk) * N + src_c0 + (lane & 31)]; }
    asm volatile("s_waitcnt lgkmcnt(0)" ::: "memory");
    const int c = lane & 7;
#pragma unroll
    for (int j = 0; j < 4; ++j) { const int n = (lane >> 3) + 8 * j; const LAS float* s = scr + (8 * c) * 33 + n;
        v4u o; o.x = pk2(s[0 * 33], s[1 * 33]); o.y = pk2(s[2 * 33], s[3 * 33]); o.z = pk2(s[4 * 33], s[5 * 33]); o.w = pk2(s[6 * 33], s[7 * 33]);
        *(v4u*)(WT + (size_t)(dst_r0 + n) * K + k0 + 8 * c) = o; }
    asm volatile("s_waitcnt lgkmcnt(0)" ::: "memory");
}

__device__ __forceinline__ void s5_table_task(const Args& a, int g, int j, LAS float* scr, int lane) {
    const float* lre = a.in[8]; const float* lim = a.in[9]; const float* ldt = a.in[10]; const float* bre = a.in[11]; const float* bim = a.in[12];
    const float* cre = a.in[13]; const float* cim = a.in[14]; const float* dsk = a.in[15];
    unsigned char* ws = a.ws;
    const int p = lane;
    const double dt = exp((double)ldt[g]);
    const double lr = (double)lre[g * 64 + p], li = (double)lim[g * 64 + p];
    const double zr = lr * dt, zi = li * dt;
    double sn, cs; sincos((double)j * zi, &sn, &cs); const double mag = exp((double)j * zr); const double Er = mag * cs, Ei = mag * sn;
    double s1, c1; sincos(zi, &s1, &c1); const double m1 = exp(zr); const double lbr = m1 * c1, lbi = m1 * s1;
    const double nr = lbr - 1.0, ni = lbi, den = lr * lr + li * li; const double cr = (nr * lr + ni * li) / den, ci = (ni * lr - nr * li) / den;
    const float Fr = (float)(Er * cr - Ei * ci), Fi = (float)(Er * ci + Ei * cr);
    const float Epr = (float)(Er * lbr - Ei * lbi), Epi = (float)(Er * lbi + Ei * lbr);
    { const f32x4* br4 = (const f32x4*)(bre + ((size_t)g * 64 + p) * 16); const f32x4* bi4 = (const f32x4*)(bim + ((size_t)g * 64 + p) * 16);
      bf16* m1r = (bf16*)(ws + WS_M1) + ((size_t)g * 128 + p) * 1024 + (63 - j) * 16; bf16* m1i = m1r + (size_t)64 * 1024;
      f32x2* bbar = (f32x2*)(ws + WS_SMALL + 128 * 1024) + ((size_t)g * 64 + p) * 16;
      unsigned wr[8], wi[8];
#pragma unroll
      for (int q = 0; q < 4; ++q) { const f32x4 br = br4[q], bi = bi4[q]; f32x4 gr, gi;
#pragma unroll
          for (int e = 0; e < 4; ++e) { gr[e] = Fr * br[e] - Fi * bi[e]; gi[e] = Fr * bi[e] + Fi * br[e]; }
          *(LAS f32x4*)(scr + p * 16 + 4 * q) = gr; *(LAS f32x4*)(scr + 1024 + p * 16 + 4 * q) = gi;
          wr[2 * q] = pk2(gr[0], gr[1]); wr[2 * q + 1] = pk2(gr[2], gr[3]); wi[2 * q] = pk2(gi[0], gi[1]); wi[2 * q + 1] = pk2(gi[2], gi[3]);
          if (j == 0) {
#pragma unroll
              for (int e = 0; e < 4; ++e) bbar[4 * q + e] = (f32x2){gr[e], gi[e]}; } }
      *(v4u*)(m1r) = (v4u){wr[0], wr[1], wr[2], wr[3]}; *(v4u*)(m1r + 8) = (v4u){wr[4], wr[5], wr[6], wr[7]};
      *(v4u*)(m1i) = (v4u){wi[0], wi[1], wi[2], wi[3]}; *(v4u*)(m1i + 8) = (v4u){wi[4], wi[5], wi[6], wi[7]}; }
    { bf16* m2 = (bf16*)(ws + WS_M2) + ((size_t)g * 1024 + j * 16) * 128;
#pragma unroll 4
      for (int ho = 0; ho < 16; ++ho) { const float c_r = cre[((size_t)g * 16 + ho) * 64 + p], c_i = cim[((size_t)g * 16 + ho) * 64 + p];
          m2[ho * 128 + p] = (bf16)f2bf(c_r * Epr - c_i * Epi); m2[ho * 128 + 64 + p] = (bf16)f2bf(-(c_r * Epi + c_i * Epr)); } }
    if (j == 0) ((f32x2*)(ws + WS_SMALL + 32 * 1024))[g * 64 + p] = (f32x2){(float)lbr, (float)lbi};
    if (j == 63) ((f32x2*)(ws + WS_SMALL + 64 * 1024))[g * 64 + p] = (f32x2){Epr, Epi};
    asm volatile("s_waitcnt lgkmcnt(0)" ::: "memory");
    { const int ho = lane >> 2, hi0 = (lane & 3) * 4; f32x4 acc = (f32x4){0.f, 0.f, 0.f, 0.f};
      const float* crow = cre + ((size_t)g * 16 + ho) * 64; const float* cirow = cim + ((size_t)g * 16 + ho) * 64;
#pragma unroll 4
      for (int pp = 0; pp < 64; ++pp) { const float c_r = crow[pp], c_i = cirow[pp];
          const f32x4 gr = *(const LAS f32x4*)(scr + pp * 16 + hi0), gi = *(const LAS f32x4*)(scr + 1024 + pp * 16 + hi0);
          acc += gr * c_r - gi * c_i; }
      if (j == 0) {
#pragma unroll
          for (int e = 0; e < 4; ++e) if (ho == hi0 + e) acc[e] += dsk[g * 16 + ho]; }
      bf16* kt = (bf16*)(ws + WS_KTAB) + (((size_t)g * 64 + j) * 16 + ho) * 16 + hi0;
      *(v2u*)kt = (v2u){pk2(acc[0], acc[1]), pk2(acc[2], acc[3])}; }
    asm volatile("s_waitcnt lgkmcnt(0)" ::: "memory");
}

__device__ __forceinline__ void ln0_row(const float* xrow, const float* g0, const float* b0, bf16* orow, float* ifrow, const f32x4 (&wif)[16][2], const float* bif, int lane) {
    const f32x4* xr = (const f32x4*)xrow + lane;
    f32x4 v[4]; float s = 0.f;
#pragma unroll
    for (int j = 0; j < 4; ++j) { v[j] = xr[64 * j]; s += (v[j].x + v[j].y) + (v[j].z + v[j].w); }
    const float mean = wave_sum(s) * (1.f / D); float s2 = 0.f;
#pragma unroll
    for (int j = 0; j < 4; ++j) { v[j] = v[j] - mean; s2 += (v[j].x * v[j].x + v[j].y * v[j].y) + (v[j].z * v[j].z + v[j].w * v[j].w); }
    const float rstd = 1.f / sqrtf(wave_sum(s2) * (1.f / D) + LN_EPS);
    unsigned long long* o8 = (unsigned long long*)orow + lane;
    float pif[8];
#pragma unroll
    for (int c = 0; c < 8; ++c) pif[c] = 0.f;
#pragma unroll
    for (int j = 0; j < 4; ++j) { const f32x4 gg = ((const f32x4*)g0)[lane + 64 * j], bb = ((const f32x4*)b0)[lane + 64 * j];
        const f32x4 y = v[j] * rstd * gg + bb;
        o8[64 * j] = (unsigned long long)pk2(y.x, y.y) | ((unsigned long long)pk2(y.z, y.w) << 32);
#pragma unroll
        for (int e = 0; e < 4; ++e) {
#pragma unroll
            for (int c = 0; c < 4; ++c) { pif[c] += y[e] * wif[4 * j + e][0][c]; pif[4 + c] += y[e] * wif[4 * j + e][1][c]; } } }
#pragma unroll
    for (int c = 0; c < 8; ++c) pif[c] = wave_sum(pif[c]);
    float outv = pif[0];
#pragma unroll
    for (int c = 1; c < 8; ++c) outv = (lane == c) ? pif[c] : outv;
    if (lane < 8) ifrow[lane] = outv + bif[lane];
}

__device__ __forceinline__ void p0_prologue(const Args& a, LAS unsigned char* lds, int vcu, int G, int wave, int lane) {
    unsigned char* ws = a.ws;
    LAS float* scr = (LAS float*)(lds + wave * 16384);
    const int gw = vcu * NWAVES + wave, NGW = G * NWAVES;
    for (int t = gw; t < S5G * 64; t += NGW) s5_table_task(a, t >> 6, t & 63, scr, lane);
    constexpr int I_IN = 16 * (NIN / 32), I_GLU = 8 * 64, I_MO = 16 * 32, I_O = 16 * 32, I_UP = 16 * 128, I_DN = 64 * 32;
    constexpr int NITEMS = I_IN + I_GLU + I_MO + I_O + I_UP + I_DN;
    for (int it = gw; it < NITEMS; it += NGW) {
        int r = it;
        if (r < I_IN) { const int nblk = NIN / 32, kb = r / nblk, nb = r % nblk, dst = 32 * nb; transpose_item(a.in[4], D, INW, (bf16*)(ws + WS_WIN), dst, dst < IFCOL ? dst : dst + 8, 64 * kb, scr, lane); continue; } r -= I_IN;
        if (r < I_GLU) { const int kb = r / 64, nb = r % 64, dst = 32 * nb; const int pn = dst >> 8, half = (dst >> 7) & 1, c = dst & 127;
            transpose_item(a.in[16], S5W, 2 * D, (bf16*)(ws + WS_WGLU), dst, half * D + 128 * pn + c, 64 * kb, scr, lane); continue; } r -= I_GLU;
        if (r < I_MO) { const int kb = r / 32, nb = r % 32; transpose_item(a.in[18], D, D, (bf16*)(ws + WS_WMO), 32 * nb, 32 * nb, 64 * kb, scr, lane); continue; } r -= I_MO;
        if (r < I_O) { const int kb = r / 32, nb = r % 32; transpose_item(a.in[19], D, D, (bf16*)(ws + WS_WO), 32 * nb, 32 * nb, 64 * kb, scr, lane); continue; } r -= I_O;
        if (r < I_UP) { const int kb = r / 128, nb = r % 128; transpose_item(a.in[22], D, FF, (bf16*)(ws + WS_WUP), 32 * nb, 32 * nb, 64 * kb, scr, lane); continue; } r -= I_UP;
        { const int kb = r / 32, nb = r % 32; transpose_item(a.in[24], FF, D, (bf16*)(ws + WS_WDN), 32 * nb, 32 * nb, 64 * kb, scr, lane); }
    }
    { float* bp = (float*)(ws + WS_SMALL); const float* bin = a.in[5];
      for (int i = gw * 64 + lane; i < NIN; i += NGW * 64) bp[i] = bin[i < IFCOL ? i : i + 8]; }
    { f32x4 wif[16][2]; const float* win = a.in[4];
#pragma unroll
      for (int j = 0; j < 4; ++j)
#pragma unroll
          for (int e = 0; e < 4; ++e) { const int k = 4 * lane + 256 * j + e; const f32x4* wp = (const f32x4*)(win + (size_t)k * INW + IFCOL); wif[4 * j + e][0] = wp[0]; wif[4 * j + e][1] = wp[1]; }
      const float* bif = a.in[5] + IFCOL;
      for (int m = gw; m < NROWS_LN0; m += NGW) { const float* xrow = m < MR ? a.in[0] + (size_t)m * D : a.in[1] + (size_t)(m - MR) * D;
          ln0_row(xrow, a.in[2], a.in[3], (bf16*)(ws + WS_H0) + (size_t)m * D, (float*)(ws + WS_IF) + (size_t)m * 8, wif, bif, lane); } }
}

__device__ __forceinline__ void s5a_phase(const Args& a, int vcu, int G, int wave, int lane) {
    unsigned char* ws = a.ws; const int fr = lane & 15, fq = lane >> 4;
    const bf16* P = (const bf16*)(ws + WS_P); const bf16* M1 = (const bf16*)(ws + WS_M1); float* S = (float*)(ws + WS_S);
    for (int it = vcu; it < S5G * 63; it += G) { const int g = it / 63, c = it % 63;
        const bf16* ap = M1 + ((size_t)g * 128 + 16 * wave + fr) * 1024 + 8 * fq;
        const bf16* bp = P + ((size_t)fr * SEQ + 64 * c + (fq >> 1)) * NIN + PU + g * 16 + 8 * (fq & 1);
        f32x4 acc = (f32x4){0.f, 0.f, 0.f, 0.f};
#pragma unroll 8
        for (int kk = 0; kk < 32; ++kk) { const bf16x8 af = *(const bf16x8*)(ap + 32 * kk), bf = *(const bf16x8*)(bp + (size_t)(2 * kk) * NIN);
            acc = __builtin_amdgcn_mfma_f32_16x16x32_bf16(af, bf, acc, 0, 0, 0); }
        *(f32x4*)(S + (((size_t)c * S5G + g) * 16 + fr) * 128 + 16 * wave + 4 * fq) = acc; }
}
__device__ __forceinline__ void s5b_phase(const Args& a, int vcu, int G, int tid) {
    unsigned char* ws = a.ws;
    const bf16* P = (const bf16*)(ws + WS_P); const float* S = (const float*)(ws + WS_S); bf16* XB = (bf16*)(ws + WS_X);
    const f32x2* LB = (const f32x2*)(ws + WS_SMALL + 32 * 1024); const f32x2* LB64 = (const f32x2*)(ws + WS_SMALL + 64 * 1024); const f32x2* BBAR = (const f32x2*)(ws + WS_SMALL + 128 * 1024);
    for (int id = vcu * NTHR + tid; id < S5G * 16 * 64; id += G * NTHR) { const int p = id & 63, b = (id >> 6) & 15, g = id >> 10;
        const f32x2 lb = LB[g * 64 + p], l64 = LB64[g * 64 + p];
        float xr = 0.f, xi = 0.f;
        for (int s = 0; s < NMETA; ++s) { const bf16* up = P + (size_t)(META0 + s) * NIN + PU + g * 16; float br = 0.f, bi = 0.f;
#pragma unroll
            for (int hi = 0; hi < 16; ++hi) { const f32x2 bb = BBAR[((size_t)g * 64 + p) * 16 + hi]; const float u = bf2f(up[hi]); br += bb.x * u; bi += bb.y * u; }
            const float nr = lb.x * xr - lb.y * xi + br, ni = lb.x * xi + lb.y * xr + bi; xr = nr; xi = ni; }
        bf16* xo = XB + (((size_t)0 * S5G + g) * 16 + b) * 128; xo[p] = (bf16)f2bf(xr); xo[64 + p] = (bf16)f2bf(xi);
#pragma unroll 4
        for (int c = 0; c < 63; ++c) { const float* sp = S + (((size_t)c * S5G + g) * 16 + b) * 128; const float sr = sp[p], si = sp[64 + p];
            const float nr = l64.x * xr - l64.y * xi + sr, ni = l64.x * xi + l64.y * xr + si; xr = nr; xi = ni;
            bf16* xo2 = XB + (((size_t)(c + 1) * S5G + g) * 16 + b) * 128; xo2[p] = (bf16)f2bf(xr); xo2[64 + p] = (bf16)f2bf(xi); } }
}
__device__ __forceinline__ void s5c_phase(const Args& a, LAS unsigned char* lds, int vcu, int G, int tid, int wave, int lane) {
    unsigned char* ws = a.ws; const int fr = lane & 15, fq = lane >> 4;
    const bf16* P = (const bf16*)(ws + WS_P); const bf16* M2 = (const bf16*)(ws + WS_M2); const bf16* XB = (const bf16*)(ws + WS_X); const bf16* KTAB = (const bf16*)(ws + WS_KTAB);
    bf16* GO = (bf16*)(ws + WS_G);
    constexpr int KT_BYTES = 65 * 512, U_OFF = KT_BYTES, U_ROW = 2064;
    int gl = -1;
    for (int it = vcu; it < S5G * NCH; it += G) { const int g = it >> 6, c = it & 63;
        __syncthreads();
        if (g != gl) { gl = g;
            for (int i = tid; i < 65 * 32; i += NTHR) { const int e = i >> 5, q = i & 31; v4u v = (v4u){0u, 0u, 0u, 0u}; if (e > 0) v = *(const v4u*)(KTAB + ((size_t)g * 64 + (e - 1)) * 256 + q * 8); *(LAS v4u*)(lds + e * 512 + q * 16) = v; } }
        for (int i = tid; i < 16 * 64 * 2; i += NTHR) { const int hh = i & 1, s = (i >> 1) & 63, b = i >> 7;
            const v4u v = *(const v4u*)(P + ((size_t)b * SEQ + 64 * c + s) * NIN + PU + g * 16 + 8 * hh); *(LAS v4u*)(lds + U_OFF + b * U_ROW + s * 32 + hh * 16) = v; }
        __syncthreads();
        bf16x8 xf[4];
#pragma unroll
        for (int ks = 0; ks < 4; ++ks) xf[ks] = *(const bf16x8*)(XB + (((size_t)c * S5G + g) * 16 + fr) * 128 + 32 * ks + 8 * fq);
        for (int tt = 0; tt < 8; ++tt) { const int t = wave + 8 * tt;
            f32x4 acc = (f32x4){0.f, 0.f, 0.f, 0.f};
            const bf16* m2p = M2 + ((size_t)g * 1024 + t * 16 + fr) * 128 + 8 * fq;
#pragma unroll
            for (int ks = 0; ks < 4; ++ks) acc = __builtin_amdgcn_mfma_f32_16x16x32_bf16(*(const bf16x8*)(m2p + 32 * ks), xf[ks], acc, 0, 0, 0);
            const int nk = (t >> 1) + 1;
            const LAS unsigned char* ab = lds + (t + 1 - (fq >> 1)) * 512 + fr * 32 + (fq & 1) * 16;
            const LAS unsigned char* bb = lds + U_OFF + fr * U_ROW + (fq >> 1) * 32 + (fq & 1) * 16;
            for (int kk = 0; kk < nk; ++kk) { const bf16x8 af = *(const LAS bf16x8*)(ab - kk * 1024), bf = *(const LAS bf16x8*)(bb + kk * 64);
                acc = __builtin_amdgcn_mfma_f32_16x16x32_bf16(af, bf, acc, 0, 0, 0); }
            v2u o; o.x = pk2(gelu_tanh(acc[0]), gelu_tanh(acc[1])); o.y = pk2(gelu_tanh(acc[2]), gelu_tanh(acc[3]));
            *(v2u*)(GO + ((size_t)fr * SEQ + 64 * c + t) * S5W + g * 16 + 4 * fq) = o; }
    }
}

constexpr int QS = 272, VS = 144;
constexpr int ML_Q = 0, ML_K = ML_Q + 64 * QS, ML_VT = ML_K + 64 * QS, ML_KWT = ML_VT + 256 * VS, ML_SP = ML_KWT + 128 * VS, ML_GATE = ML_SP + 64 * VS;
constexpr int ML_A = ML_GATE, ML_MS = ML_GATE + 256, ML_WI = ML_GATE + 512, ML_EM = ML_GATE + 768, ML_WK = ML_GATE + 1024, ML_QN = ML_GATE + 1280, ML_RS = ML_GATE + 1536  ,
              ML_NV = ML_GATE + 2560  , ML_SC = ML_GATE + 3072  , ML_HS = ML_GATE + 3136  , ML_END = ML_HS + 4096;
static_assert(ML_END <= LDS_BYTES - 256, "mlstm lds");

__device__ __forceinline__ void mlstm_chain(const Args& a, LAS unsigned char* lds, int b, int h, int tid, int wave, int lane) {
    unsigned char* ws = a.ws; const int fr = lane & 15, fq = lane >> 4;
    const bf16* P = (const bf16*)(ws + WS_P); const float* IFG = (const float*)(ws + WS_IF);
    bf16* A2 = (bf16*)a.out;
    const float* cw = a.in[6]; const float* cb = a.in[7]; const float* ng = a.in[17];
    LAS float* gA = (LAS float*)(lds + ML_A); LAS float* gMS = (LAS float*)(lds + ML_MS); LAS float* gWI = (LAS float*)(lds + ML_WI); LAS float* gEM = (LAS float*)(lds + ML_EM);
    LAS float* gWK = (LAS float*)(lds + ML_WK); LAS float* gQN = (LAS float*)(lds + ML_QN); LAS float* gRS = (LAS float*)(lds + ML_RS); LAS float* gNV = (LAS float*)(lds + ML_NV);
    LAS float* gSC = (LAS float*)(lds + ML_SC); LAS float* gHS = (LAS float*)(lds + ML_HS);
    f32x4 accC[8][2];
#pragma unroll
    for (int i = 0; i < 8; ++i) { accC[i][0] = (f32x4){0.f, 0.f, 0.f, 0.f}; accC[i][1] = (f32x4){0.f, 0.f, 0.f, 0.f}; }
    __syncthreads();
    if (tid < 128) gNV[tid] = 0.f;
    if (tid == 0) gSC[0] = 0.f;
    __syncthreads();
    const LAS unsigned char* qfrag = lds + ML_Q + fr * QS + fq * 16;
    const LAS unsigned char* kfrag = lds + ML_K + fr * QS + fq * 16;
    const LAS unsigned char* qperm = lds + ML_Q + fr * QS + fq * 8;
    const LAS unsigned char* vfrag = lds + ML_VT + (32 * wave + fr) * VS + fq * 16;
    const LAS unsigned char* kwfrag = lds + ML_KWT + fr * VS + fq * 16;
    const LAS unsigned char* spfrag = lds + ML_SP + fr * VS + fq * 16;
    for (int c = 0; c <= NCH; ++c) {
        if (wave == 0) { const int sp = 64 * c + lane - 48; const bool valid = sp >= 0; const int row = sp < NMETA ? META0 + sp : b * SEQ + (sp - NMETA);
            float li = -INFINITY, lf = 0.f;
            if (valid) { li = IFG[(size_t)row * 8 + h]; lf = log_sigmoid(IFG[(size_t)row * 8 + 4 + h]); }
            float bc = lf;
#pragma unroll
            for (int o = 1; o < 64; o <<= 1) { const float t = __shfl_up(bc, o); if (lane >= o) bc += t; }
            const float av = li - bc; float pm = av;
#pragma unroll
            for (int o = 1; o < 64; o <<= 1) { const float t = __shfl_up(pm, o); if (lane >= o) pm = fmaxf(pm, t); }
            const float mprev = gSC[0]; const float Ms = fmaxf(mprev, pm);
            const float M63 = __shfl(Ms, 63), bl = __shfl(bc, 63);
            gA[lane] = av; gMS[lane] = Ms; gWI[lane] = __expf(mprev - Ms); gEM[lane] = __expf(-(bc + Ms)); gWK[lane] = __expf(av - M63);
            if (lane == 0) { gSC[1] = bl + M63; gSC[2] = __expf(mprev - M63); } }
        __syncthreads();
#pragma unroll 1
        for (int i = tid; i < 2048; i += NTHR) { const int isk = i >> 10, j = (i >> 4) & 63, cg = i & 15; const int sp = 64 * c + j - 48;
            float o8[8];
#pragma unroll
            for (int e = 0; e < 8; ++e) o8[e] = 0.f;
            if (sp >= 0) { const int ch = isk * 512 + h * DK + 8 * cg;
                const f32x4 b0 = *(const f32x4*)(cb + ch), b1 = *(const f32x4*)(cb + ch + 4);
#pragma unroll
                for (int e = 0; e < 4; ++e) { o8[e] = b0[e]; o8[4 + e] = b1[e]; }
#pragma unroll
                for (int w = 0; w < 4; ++w) { const int s2 = sp - 3 + w; if (s2 >= 0) { const int row = s2 < NMETA ? META0 + s2 : b * SEQ + (s2 - NMETA);
                        const v4u x = *(const v4u*)(P + (size_t)row * NIN + PQ + ch); const f32x4 w0 = *(const f32x4*)(cw + w * 1024 + ch), w1 = *(const f32x4*)(cw + w * 1024 + ch + 4);
                        o8[0] += w0[0] * bflo(x.x); o8[1] += w0[1] * bfhi(x.x); o8[2] += w0[2] * bflo(x.y); o8[3] += w0[3] * bfhi(x.y);
                        o8[4] += w1[0] * bflo(x.z); o8[5] += w1[1] * bfhi(x.z); o8[6] += w1[2] * bflo(x.w); o8[7] += w1[3] * bfhi(x.w); } }
                const float sc = isk ? 0.08838834764831845f : 1.f;
#pragma unroll
                for (int e = 0; e < 8; ++e) o8[e] = o8[e] * sigmf(o8[e]) * sc; }
            const v4u pk = (v4u){pk2(o8[0], o8[1]), pk2(o8[2], o8[3]), pk2(o8[4], o8[5]), pk2(o8[6], o8[7])};
            *(LAS v4u*)(lds + (isk ? ML_K : ML_Q) + j * QS + cg * 16) = pk;
            if (isk) { const float wk = gWK[j]; LAS unsigned char* kw = lds + ML_KWT + (8 * cg) * VS + j * 2;
#pragma unroll
                for (int e = 0; e < 8; ++e) *(LAS bf16*)(kw + e * VS) = (bf16)f2bf(o8[e] * wk); } }
#pragma unroll 1
        for (int i = tid; i < 2048; i += NTHR) { const int j = i >> 5, eg = i & 31; const int sp = 64 * c + j - 48;
            v4u x = (v4u){0u, 0u, 0u, 0u};
            if (sp >= 0) { const int row = sp < NMETA ? META0 + sp : b * SEQ + (sp - NMETA); x = *(const v4u*)(P + (size_t)row * NIN + PV + h * DV + 8 * eg); }
            LAS unsigned char* vt = lds + ML_VT + (8 * eg) * VS + j * 2;
            *(LAS bf16*)(vt + 0 * VS) = (bf16)(x.x & 0xffffu); *(LAS bf16*)(vt + 1 * VS) = (bf16)(x.x >> 16); *(LAS bf16*)(vt + 2 * VS) = (bf16)(x.y & 0xffffu); *(LAS bf16*)(vt + 3 * VS) = (bf16)(x.y >> 16);
            *(LAS bf16*)(vt + 4 * VS) = (bf16)(x.z & 0xffffu); *(LAS bf16*)(vt + 5 * VS) = (bf16)(x.z >> 16); *(LAS bf16*)(vt + 6 * VS) = (bf16)(x.w & 0xffffu); *(LAS bf16*)(vt + 7 * VS) = (bf16)(x.w >> 16); }
        __syncthreads();
        if (c > 0) {
#pragma unroll
            for (int i2 = 0; i2 < 2; ++i2) { const int tile = 2 * wave + i2, jt = tile >> 2, st = tile & 3;
                f32x4 acc = (f32x4){0.f, 0.f, 0.f, 0.f};
                if (jt <= st) {
#pragma unroll
                    for (int ks = 0; ks < 4; ++ks) { const bf16x8 af = *(const LAS bf16x8*)(kfrag + jt * 16 * QS + ks * 64), bf = *(const LAS bf16x8*)(qfrag + st * 16 * QS + ks * 64);
                        acc = __builtin_amdgcn_mfma_f32_16x16x32_bf16(af, bf, acc, 0, 0, 0); } }
                const int s = 16 * st + fr, j0 = 16 * jt + 4 * fq; const float Ms = gMS[s]; float rs = 0.f; float sv[4];
#pragma unroll
                for (int r = 0; r < 4; ++r) { const int j = j0 + r; const float w = (j <= s) ? __expf(gA[j] - Ms) : 0.f; sv[r] = acc[r] * w; rs += sv[r]; }
                rs += __shfl_xor(rs, 16); rs += __shfl_xor(rs, 32);
                if (fq == 0) gRS[s * 4 + jt] = rs;
                *(LAS v2u*)(lds + ML_SP + s * VS + j0 * 2) = (v2u){pk2(sv[0], sv[1]), pk2(sv[2], sv[3])}; }
            { const int s = 8 * wave + (lane >> 3), ds = lane & 7; float q = 0.f;
#pragma unroll
              for (int hh = 0; hh < 2; ++hh) { const v4u x = *(const LAS v4u*)(lds + ML_Q + s * QS + (2 * ds + hh) * 16); const LAS float* nv = gNV + 16 * ds + 8 * hh;
                  q += bflo(x.x) * nv[0] + bfhi(x.x) * nv[1] + bflo(x.y) * nv[2] + bfhi(x.y) * nv[3] + bflo(x.z) * nv[4] + bfhi(x.z) * nv[5] + bflo(x.w) * nv[6] + bfhi(x.w) * nv[7]; }
              q += __shfl_xor(q, 1); q += __shfl_xor(q, 2); q += __shfl_xor(q, 4);
              if (ds == 0) gQN[s] = q; }
            __syncthreads();
            f32x4 accN[2][4];
#pragma unroll
            for (int et = 0; et < 2; ++et)
#pragma unroll
                for (int st = 0; st < 4; ++st) accN[et][st] = (f32x4){0.f, 0.f, 0.f, 0.f};
#pragma unroll
            for (int ks = 0; ks < 4; ++ks) { bf16x8 af[2], bf[4];
#pragma unroll
                for (int et = 0; et < 2; ++et) { const f32x4 lo = accC[2 * ks][et], hi4 = accC[2 * ks + 1][et];
                    const v4u w = (v4u){pk2(lo[0], lo[1]), pk2(lo[2], lo[3]), pk2(hi4[0], hi4[1]), pk2(hi4[2], hi4[3])}; af[et] = __builtin_bit_cast(bf16x8, w); }
#pragma unroll
                for (int st = 0; st < 4; ++st) { const v2u l2 = *(const LAS v2u*)(qperm + st * 16 * QS + ks * 64), h2 = *(const LAS v2u*)(qperm + st * 16 * QS + ks * 64 + 32);
                    const v4u w = (v4u){l2.x, l2.y, h2.x, h2.y}; bf[st] = __builtin_bit_cast(bf16x8, w); }
#pragma unroll
                for (int et = 0; et < 2; ++et)
#pragma unroll
                    for (int st = 0; st < 4; ++st) accN[et][st] = __builtin_amdgcn_mfma_f32_16x16x32_bf16(af[et], bf[st], accN[et][st], 0, 0, 0); }
            float dn[4];
#pragma unroll
            for (int st = 0; st < 4; ++st) { const int s = 16 * st + fr; const float wi = gWI[s];
                accN[0][st] = accN[0][st] * wi; accN[1][st] = accN[1][st] * wi;
                const f32x4 rs4 = *(const LAS f32x4*)(gRS + s * 4); const float den = (rs4[0] + rs4[1]) + (rs4[2] + rs4[3]) + wi * gQN[s];
                dn[st] = __builtin_amdgcn_rcpf(fmaxf(fabsf(den), gEM[s])); }
#pragma unroll
            for (int ks = 0; ks < 2; ++ks) { bf16x8 af[2], bf[4];
#pragma unroll
                for (int et = 0; et < 2; ++et) af[et] = *(const LAS bf16x8*)(vfrag + et * 16 * VS + ks * 64);
#pragma unroll
                for (int st = 0; st < 4; ++st) bf[st] = *(const LAS bf16x8*)(spfrag + st * 16 * VS + ks * 64);
#pragma unroll
                for (int et = 0; et < 2; ++et)
#pragma unroll
                    for (int st = 0; st < 4; ++st) accN[et][st] = __builtin_amdgcn_mfma_f32_16x16x32_bf16(af[et], bf[st], accN[et][st], 0, 0, 0); }
#pragma unroll
            for (int st = 0; st < 4; ++st) { float s1 = 0.f, s2 = 0.f;
#pragma unroll
                for (int et = 0; et < 2; ++et) { accN[et][st] = accN[et][st] * dn[st];
#pragma unroll
                    for (int r = 0; r < 4; ++r) { const float v = accN[et][st][r]; s1 += v; s2 += v * v; } }
                s1 += __shfl_xor(s1, 16); s1 += __shfl_xor(s1, 32); s2 += __shfl_xor(s2, 16); s2 += __shfl_xor(s2, 32);
                if (fq == 0) *(LAS f32x2*)(gHS + ((16 * st + fr) * 8 + wave) * 2) = (f32x2){s1, s2}; }
            __syncthreads();
#pragma unroll
            for (int st = 0; st < 4; ++st) { const int s = 16 * st + fr; float s1 = 0.f, s2 = 0.f;
#pragma unroll
                for (int w2 = 0; w2 < 4; ++w2) { const f32x4 t = *(const LAS f32x4*)(gHS + (s * 8 + 2 * w2) * 2); s1 += t[0] + t[2]; s2 += t[1] + t[3]; }
                const float mean = s1 * (1.f / DV), var = fmaxf(s2 * (1.f / DV) - mean * mean, 0.f), rstd = 1.f / sqrtf(var + LN_EPS);
                const size_t row = (size_t)b * SEQ + 64 * (c - 1) + s;
#pragma unroll
                for (int et = 0; et < 2; ++et) { const int e0 = h * DV + 32 * wave + 16 * et + 4 * fq;
                    const v2u so = *(const v2u*)(P + row * NIN + PO + e0); const f32x4 gg = *(const f32x4*)(ng + e0); const f32x4 sof = pg8::bf4f(so.x, so.y);
                    const f32x4 o = (accN[et][st] - mean) * rstd * gg * sof;
                    *(v2u*)(A2 + row * D + e0) = (v2u){pk2(o[0], o[1]), pk2(o[2], o[3])}; } }
        }
        { const float decay = gSC[2];
#pragma unroll
          for (int dt = 0; dt < 8; ++dt) { accC[dt][0] = accC[dt][0] * decay; accC[dt][1] = accC[dt][1] * decay; }
#pragma unroll
          for (int ks = 0; ks < 2; ++ks) { bf16x8 bf[2];
#pragma unroll
              for (int et = 0; et < 2; ++et) bf[et] = *(const LAS bf16x8*)(vfrag + et * 16 * VS + ks * 64);
#pragma unroll
              for (int dt = 0; dt < 8; ++dt) { const bf16x8 af = *(const LAS bf16x8*)(kwfrag + dt * 16 * VS + ks * 64);
                  accC[dt][0] = __builtin_amdgcn_mfma_f32_16x16x32_bf16(af, bf[0], accC[dt][0], 0, 0, 0); accC[dt][1] = __builtin_amdgcn_mfma_f32_16x16x32_bf16(af, bf[1], accC[dt][1], 0, 0, 0); } }
          if (tid < 128) { float nn = gNV[tid] * decay; const LAS unsigned char* kp = lds + ML_K + tid * 2;
#pragma unroll 8
              for (int j = 0; j < 64; ++j) nn += gWK[j] * bf2f(*(const LAS bf16*)(kp + j * QS));
              gNV[tid] = nn; }
          if (tid == 0) gSC[0] = gSC[1]; }
        __syncthreads();
    }
}

template <bool OUT_BF16>
__device__ __forceinline__ void ln_rows(const float* V, const float* g, const float* bta, void* O, int vcu, int G, int wave, int lane) {
    const int gw = vcu * NWAVES + wave, NGW = G * NWAVES;
    f32x4 gg[4], bb[4];
#pragma unroll
    for (int j = 0; j < 4; ++j) { gg[j] = ((const f32x4*)g)[lane + 64 * j]; bb[j] = ((const f32x4*)bta)[lane + 64 * j]; }
    for (int m = gw; m < MR; m += NGW) { const f32x4* xr = (const f32x4*)(V + (size_t)m * D) + lane;
        f32x4 v[4]; float s = 0.f;
#pragma unroll
        for (int j = 0; j < 4; ++j) { v[j] = xr[64 * j]; s += (v[j].x + v[j].y) + (v[j].z + v[j].w); }
        const float mean = wave_sum(s) * (1.f / D); float s2 = 0.f;
#pragma unroll
        for (int j = 0; j < 4; ++j) { v[j] = v[j] - mean; s2 += (v[j].x * v[j].x + v[j].y * v[j].y) + (v[j].z * v[j].z + v[j].w * v[j].w); }
        const float rstd = 1.f / sqrtf(wave_sum(s2) * (1.f / D) + LN_EPS);
#pragma unroll
        for (int j = 0; j < 4; ++j) { const f32x4 y = v[j] * rstd * gg[j] + bb[j];
            if (OUT_BF16) ((unsigned long long*)((bf16*)O + (size_t)m * D))[lane + 64 * j] = (unsigned long long)pk2(y.x, y.y) | ((unsigned long long)pk2(y.z, y.w) << 32);
            else ((f32x4*)((float*)O + (size_t)m * D))[lane + 64 * j] = y; } }
}

constexpr int NPHASE = 13;
__global__ void __launch_bounds__(NTHR, 2) fwd_kernel(Args args) {
    extern __shared__ __attribute__((aligned(16))) unsigned char lds_raw[];
    LAS unsigned char* lds = (LAS unsigned char*)lds_raw;
    const int tid = threadIdx.x, lane = tid & 63, wave = __builtin_amdgcn_readfirstlane(tid >> 6);
    const int G = gridDim.x; const int bx = blockIdx.x; const int vcu = (G % 8 == 0) ? (bx % 8) * (G / 8) + bx / 8 : bx;
    unsigned char* ws = args.ws;
    const int lo = args.ph_lo, hi = args.ph_hi;
#define IN(k) (lo <= (k) && (k) < hi)
    if (IN(0)) p0_prologue(args, lds, vcu, G, wave, lane);
    if (IN(1)) { pg8::Gemm g{(const bf16*)(ws + WS_H0), (const bf16*)(ws + WS_WIN), MT, NIN, D}; pg8::StaticOrder S; S.init(MT, NIN, G, bx);
        pg8::EpiIn E{(bf16*)(ws + WS_P), NIN, (const float*)(ws + WS_SMALL), 10};
        pg8::gemm_phase<pg8::EpiIn, pg8::StaticOrder, true, true>(lds, g, S, E); }
    if (IN(2)) s5a_phase(args, vcu, G, wave, lane);
    if (IN(3)) s5b_phase(args, vcu, G, tid);
    if (IN(4)) s5c_phase(args, lds, vcu, G, tid, wave, lane);
    if (IN(5)) { for (int ch = vcu; ch < BATCH * MH; ch += G) mlstm_chain(args, lds, ch >> 2, ch & 3, tid, wave, lane); }
    if (IN(6)) { pg8::Gemm g{(const bf16*)(ws + WS_G), (const bf16*)(ws + WS_WGLU), MR, 2 * D, S5W}; pg8::StaticOrder S; S.init(MR, 2 * D, G, bx);
        pg8::EpiGlu E{(const bf16*)(ws + WS_P) + PGS, NIN, (bf16*)args.out + (size_t)MR * D, D};
        pg8::gemm_phase<pg8::EpiGlu, pg8::StaticOrder, true, true>(lds, g, S, E); }
    if (IN(7)) { pg8::Gemm g{(const bf16*)args.out, (const bf16*)(ws + WS_WMO), MR, D, D}; pg8::StaticOrder S; S.init(MR, D, G, bx);
        pg8::EpiMo E{(const bf16*)(ws + WS_P) + PGM, NIN, (bf16*)args.out + (size_t)MR * D, D};
        pg8::gemm_phase<pg8::EpiMo, pg8::StaticOrder, true, true>(lds, g, S, E); }
    if (IN(8)) { pg8::Gemm g{(const bf16*)args.out + (size_t)MR * D, (const bf16*)(ws + WS_WO), MR, D, D}; pg8::StaticOrder S; S.init(MR, D, G, bx);
        pg8::EpiRes E{(const bf16*)(ws + WS_H0), (float*)(ws + WS_V1), D, ALPHA};
        pg8::gemm_phase<pg8::EpiRes, pg8::StaticOrder, true, true>(lds, g, S, E); }
    if (IN(9)) ln_rows<true>((const float*)(ws + WS_V1), args.in[20], args.in[21], (void*)(ws + WS_H1), vcu, G, wave, lane);
    if (IN(10)) { pg8::Gemm g{(const bf16*)(ws + WS_H1), (const bf16*)(ws + WS_WUP), MR, FF, D}; pg8::StaticOrder S; S.init(MR, FF, G, bx);
        pg8::EpiUp E{(bf16*)(ws + WS_HFF), FF, args.in[23]};
        pg8::gemm_phase<pg8::EpiUp, pg8::StaticOrder, true, true>(lds, g, S, E); }
    if (IN(11)) { pg8::Gemm g{(const bf16*)(ws + WS_HFF), (const bf16*)(ws + WS_WDN), MR, D, FF}; pg8::StaticOrder S; S.init(MR, D, G, bx);
        pg8::EpiRes E{(const bf16*)(ws + WS_H1), args.out, D, ALPHA};
        pg8::gemm_phase<pg8::EpiRes, pg8::StaticOrder, true, true>(lds, g, S, E); }
    if (IN(12)) ln_rows<false>(args.out, args.in[25], args.in[26], (void*)args.out, vcu, G, wave, lane);
#undef IN
}

extern "C" void kernel_launch(void* const* d_in, const int* in_sizes, int n_in, void* d_out, int out_size, void* d_ws, size_t ws_size, hipStream_t stream) {
    static int grid = 0;
    if (grid == 0) {
        if (n_in != 27 || in_sizes[0] != MR * D || out_size != MR * D || ws_size < WS_END) { fprintf(stderr, "kernel_launch: unexpected shapes (n_in %d, in0 %d, out %d, ws %zu); nothing launched\n", n_in, n_in > 0 ? in_sizes[0] : -1, out_size, ws_size); grid = -1; return; }
        int dev = 0, cus = 0;
        if (hipGetDevice(&dev) != hipSuccess || hipDeviceGetAttribute(&cus, hipDeviceAttributeMultiprocessorCount, dev) != hipSuccess) { grid = -1; return; }
        if (hipFuncSetAttribute((const void*)fwd_kernel, hipFuncAttributeMaxDynamicSharedMemorySize, LDS_BYTES) != hipSuccess) { fprintf(stderr, "kernel_launch: hipFuncSetAttribute failed\n"); grid = -1; return; }
        (void)hipGetLastError();
        grid = cus;
    }
    if (grid < 0) return;
    Args a{};
    for (int i = 0; i < 27; ++i) a.in[i] = (const float*)d_in[i];
    a.out = (float*)d_out; a.ws = (unsigned char*)d_ws;
    for (int ph = 0; ph < NPHASE; ++ph) { a.ph_lo = ph; a.ph_hi = ph + 1;
        hipLaunchKernelGGL(fwd_kernel, dim3(grid), dim3(NTHR), LDS_BYTES, stream, a); }
}
```

```cpp
#include <hip/hip_runtime.h>
#include <cstdio>
#include <cstdint>
namespace pg8 {
#define PG8_LAS __attribute__((address_space(3)))
typedef unsigned short bf16_t;
typedef short bf16x8 __attribute__((ext_vector_type(8)));
typedef float f32x4 __attribute__((ext_vector_type(4)));
typedef unsigned u32x4 __attribute__((ext_vector_type(4)));
constexpr int BM = 256, BK = 64, HALF = 128, HTB = HALF * BK * 2  , STAGE_BYTES = 8 * HTB, NXCD = 8, WGM = 8;

__host__ __device__ __forceinline__ int lds_byte(int r, int c) { const int st = (r >> 4) * 2 + (c >> 5), rr = r & 15, cc = c & 31, ob = rr * 64 + cc * 2; return st * 1024 + (ob ^ (((ob >> 9) & 1) << 5)); }
__host__ __device__ __forceinline__ void stage_rc(int b, int& R, int& C) { const int st = b / 1024, sb = b % 1024, swz = sb ^ (((sb >> 9) & 1) << 5); R = (st >> 1) * 16 + swz / 64; C = (st & 1) * 32 + (swz % 64) / 2; }
__host__ __device__ __forceinline__ int perm32(int rho) { const int n = rho >> 4, i = rho & 15; return 8 * (i >> 2) + 4 * n + (i & 3); }

struct Unit { int pm, pn; };
struct Gemm { const bf16_t* A; const bf16_t* Bt; int M, N, K; };

struct StaticOrder {
    int nM, nN, nwg, G, c;
    __host__ __device__ void init(int M, int N, int G_, int c_) { nM = M / BM; nN = N / BM; nwg = nM * nN; G = G_; c = c_; }
    __host__ __device__ bool next(int i, Unit& u) const {
        const long L = (long)i * G + c; if (L >= nwg) return false;
        int wgid = (int)L; { const int q = nwg / NXCD, r = nwg % NXCD, xcd = wgid % NXCD, off = wgid / NXCD; wgid = (xcd < r ? xcd * (q + 1) : r * (q + 1) + (xcd - r) * q) + off; }
        const int nig = WGM * nN, gid = wgid / nig, fm = gid * WGM, gsz = (nM - fm) < WGM ? (nM - fm) : WGM;
        u.pm = fm + ((wgid % nig) % gsz); u.pn = (wgid % nig) / gsz; return true;
    }
    __device__ __forceinline__ void a_ready(const Unit&) const {}
    __device__ __forceinline__ void done(const Unit&) const {}
};

__device__ __forceinline__ unsigned cvt_pk_bf16(float lo, float hi) { unsigned r; asm volatile("v_cvt_pk_bf16_f32 %0, %1, %2" : "=v"(r) : "v"(lo), "v"(hi)); return r; }
typedef float f32x2 __attribute__((ext_vector_type(2)));
__device__ __forceinline__ float sigm(float x) { return __builtin_amdgcn_rcpf(1.0f + __builtin_amdgcn_exp2f(-1.4426950408889634f * x)); }
__device__ __forceinline__ f32x4 bf4f(unsigned lo, unsigned hi) { return (f32x4){__uint_as_float(lo << 16), __uint_as_float(lo & 0xffff0000u), __uint_as_float(hi << 16), __uint_as_float(hi & 0xffff0000u)}; }
typedef unsigned u32x2 __attribute__((ext_vector_type(2)));

struct EpiIn {
    static constexpr bool PERM = true, AFTER_DRAIN = false;
    bf16_t* P; int ldc; const float* bias; int sig_from;
    __device__ __forceinline__ void operator()(const f32x4 (&acc)[2][2][4][2], const Unit& u, int wr, int wc, int fr, int fq) const {
        const int row0 = u.pm * BM + wr * 64 + fr, col0 = u.pn * BM + wc * 32 + 8 * fq; const bool sg = u.pn >= sig_from;
        f32x4 bv[2][2];
#pragma unroll
        for (int bj = 0; bj < 2; ++bj)
#pragma unroll
            for (int n = 0; n < 2; ++n) bv[bj][n] = *(const f32x4*)(bias + col0 + bj * HALF + 4 * n);
#pragma unroll
        for (int ai = 0; ai < 2; ++ai)
#pragma unroll
            for (int m = 0; m < 4; ++m) { bf16_t* rowp = P + (size_t)(row0 + ai * HALF + m * 16) * ldc + col0;
#pragma unroll
                for (int bj = 0; bj < 2; ++bj) { f32x4 v0 = acc[ai][bj][m][0] + bv[bj][0], v1 = acc[ai][bj][m][1] + bv[bj][1];
                    if (sg) {
#pragma unroll
                        for (int j = 0; j < 4; ++j) { v0[j] = sigm(v0[j]); v1[j] = sigm(v1[j]); } }
                    u32x4 w; w.x = cvt_pk_bf16(v0[0], v0[1]); w.y = cvt_pk_bf16(v0[2], v0[3]); w.z = cvt_pk_bf16(v1[0], v1[1]); w.w = cvt_pk_bf16(v1[2], v1[3]);
                    *(u32x4*)(rowp + bj * HALF) = w; } }
    }
};
struct EpiGlu {
    static constexpr bool PERM = true, AFTER_DRAIN = false;
    const bf16_t* SG; int ldsg; bf16_t* O; int ldo;
    __device__ __forceinline__ void operator()(const f32x4 (&acc)[2][2][4][2], const Unit& u, int wr, int wc, int fr, int fq) const {
        const int row0 = u.pm * BM + wr * 64 + fr, col = u.pn * HALF + wc * 32 + 8 * fq;
#pragma unroll
        for (int ai = 0; ai < 2; ++ai)
#pragma unroll
            for (int m = 0; m < 4; ++m) { const size_t r = (size_t)(row0 + ai * HALF + m * 16);
                const u32x4 s = *(const u32x4*)(SG + r * ldsg + col); const f32x4 s0 = bf4f(s.x, s.y), s1 = bf4f(s.z, s.w);
                f32x4 o0, o1;
#pragma unroll
                for (int j = 0; j < 4; ++j) { o0[j] = s0[j] * acc[ai][0][m][0][j] * sigm(acc[ai][1][m][0][j]); o1[j] = s1[j] * acc[ai][0][m][1][j] * sigm(acc[ai][1][m][1][j]); }
                u32x4 w; w.x = cvt_pk_bf16(o0[0], o0[1]); w.y = cvt_pk_bf16(o0[2], o0[3]); w.z = cvt_pk_bf16(o1[0], o1[1]); w.w = cvt_pk_bf16(o1[2], o1[3]);
                *(u32x4*)(O + r * ldo + col) = w; }
    }
};
struct EpiMo {
    static constexpr bool PERM = true, AFTER_DRAIN = false;
    const bf16_t* SG; int ldsg; bf16_t* O; int ldo;
    __device__ __forceinline__ void operator()(const f32x4 (&acc)[2][2][4][2], const Unit& u, int wr, int wc, int fr, int fq) const {
        const int row0 = u.pm * BM + wr * 64 + fr, col0 = u.pn * BM + wc * 32 + 8 * fq;
#pragma unroll
        for (int ai = 0; ai < 2; ++ai)
#pragma unroll
            for (int m = 0; m < 4; ++m) { const size_t r = (size_t)(row0 + ai * HALF + m * 16);
#pragma unroll
                for (int bj = 0; bj < 2; ++bj) { const int col = col0 + bj * HALF;
                    const u32x4 s = *(const u32x4*)(SG + r * ldsg + col), x = *(const u32x4*)(O + r * ldo + col);
                    const f32x4 o0 = bf4f(x.x, x.y) + bf4f(s.x, s.y) * acc[ai][bj][m][0], o1 = bf4f(x.z, x.w) + bf4f(s.z, s.w) * acc[ai][bj][m][1];
                    u32x4 w; w.x = cvt_pk_bf16(o0[0], o0[1]); w.y = cvt_pk_bf16(o0[2], o0[3]); w.z = cvt_pk_bf16(o1[0], o1[1]); w.w = cvt_pk_bf16(o1[2], o1[3]);
                    *(u32x4*)(O + r * ldo + col) = w; } }
    }
};
struct EpiRes {
    static constexpr bool PERM = false, AFTER_DRAIN = false;
    const bf16_t* R; float* V; int ldc; float alpha;
    __device__ __forceinline__ void operator()(const f32x4 (&acc)[2][2][4][2], const Unit& u, int wr, int wc, int fr, int fq) const {
        const int row0 = u.pm * BM + wr * 64 + fr, col0 = u.pn * BM + wc * 32 + 4 * fq;
#pragma unroll
        for (int ai = 0; ai < 2; ++ai)
#pragma unroll
            for (int m = 0; m < 4; ++m) { const size_t off = (size_t)(row0 + ai * HALF + m * 16) * ldc + col0;
#pragma unroll
                for (int bj = 0; bj < 2; ++bj)
#pragma unroll
                    for (int n = 0; n < 2; ++n) { const u32x2 x = *(const u32x2*)(R + off + bj * HALF + n * 16);
                        *(f32x4*)(V + off + bj * HALF + n * 16) = bf4f(x.x, x.y) * alpha + acc[ai][bj][m][n]; } }
    }
};
struct EpiUp {
    static constexpr bool PERM = true, AFTER_DRAIN = false;
    bf16_t* O; int ldc; const float* bias;
    __device__ __forceinline__ void operator()(const f32x4 (&acc)[2][2][4][2], const Unit& u, int wr, int wc, int fr, int fq) const {
        const int row0 = u.pm * BM + wr * 64 + fr, col0 = u.pn * BM + wc * 32 + 8 * fq;
        f32x4 bv[2][2];
#pragma unroll
        for (int bj = 0; bj < 2; ++bj)
#pragma unroll
            for (int n = 0; n < 2; ++n) bv[bj][n] = *(const f32x4*)(bias + col0 + bj * HALF + 4 * n);
#pragma unroll
        for (int ai = 0; ai < 2; ++ai)
#pragma unroll
            for (int m = 0; m < 4; ++m) { bf16_t* rowp = O + (size_t)(row0 + ai * HALF + m * 16) * ldc + col0;
#pragma unroll
                for (int bj = 0; bj < 2; ++bj) { f32x4 v0 = acc[ai][bj][m][0] + bv[bj][0], v1 = acc[ai][bj][m][1] + bv[bj][1];
#pragma unroll
                    for (int j = 0; j < 4; ++j) { const float a = fmaxf(v0[j], 0.f), b = fmaxf(v1[j], 0.f); v0[j] = a * a; v1[j] = b * b; }
                    u32x4 w; w.x = cvt_pk_bf16(v0[0], v0[1]); w.y = cvt_pk_bf16(v0[2], v0[3]); w.z = cvt_pk_bf16(v1[0], v1[1]); w.w = cvt_pk_bf16(v1[2], v1[3]);
                    *(u32x4*)(rowp + bj * HALF) = w; } }
    }
};
template <class Epi, class Sched, bool ALIGN_EPI = false, bool SP2 = false>
__device__ __forceinline__ void gemm_phase(PG8_LAS unsigned char* lds, const Gemm g, const Sched& S, const Epi& E) {
    const int tid = threadIdx.x, wid = __builtin_amdgcn_readfirstlane(tid >> 6), lane = tid & 63, wr = wid >> 2, wc = wid & 3, fr = lane & 15, fq = lane >> 4;
    const int K = g.K, nt = K / BK;
    unsigned voffA[2], voffB[2];
#pragma unroll
    for (int i = 0; i < 2; ++i) { int R, C; stage_rc(tid * 16 + i * 8192, R, C); const int Rb = Epi::PERM ? ((R & ~31) + perm32(R & 31)) : R;
        voffA[i] = (unsigned)(R * K + C) * 2u; voffB[i] = (unsigned)(Rb * K + C) * 2u; }
    const size_t kstep = (size_t)(BK * 2);
    const size_t hstep = (size_t)HALF * K * 2;
    const size_t tstep = 2 * hstep;
    const unsigned ldsw = (unsigned)wid * 1024u;
    const int aoff = lds_byte(wr * 64 + fr, fq * 8), boff = lds_byte(wc * 32 + fr, fq * 8);
#define PG8_SA(b, h) (((b) * 2 + (h)) * HTB)
#define PG8_SB(b, h) ((4 + (b) * 2 + (h)) * HTB)
#define PG8_STAGE(bufoff, gbase, voff) do { _Pragma("unroll") for (int _i = 0; _i < 2; ++_i) \
        __builtin_amdgcn_global_load_lds((const unsigned*)((const char*)(gbase) + (voff)[_i]), (PG8_LAS unsigned*)(lds + (bufoff) + ldsw + _i * 8192), 16, 0, 0); } while (0)
#define PG8_LDA(dst, b, h) do { _Pragma("unroll") for (int m = 0; m < 4; ++m) _Pragma("unroll") for (int k = 0; k < 2; ++k) dst[m][k] = *(const PG8_LAS bf16x8*)(lds + PG8_SA(b, h) + aoff + m * 2048 + k * 1024); } while (0)
#define PG8_LDB(dst, b, h) do { _Pragma("unroll") for (int n = 0; n < 2; ++n) _Pragma("unroll") for (int k = 0; k < 2; ++k) dst[n][k] = *(const PG8_LAS bf16x8*)(lds + PG8_SB(b, h) + boff + n * 2048 + k * 1024); } while (0)
#define PG8_MMA(ai, bj, At, Bt) do { __builtin_amdgcn_s_setprio(1); _Pragma("unroll") for (int m = 0; m < 4; ++m) _Pragma("unroll") for (int n = 0; n < 2; ++n) _Pragma("unroll") for (int k = 0; k < 2; ++k) \
        acc[ai][bj][m][n] = __builtin_amdgcn_mfma_f32_16x16x32_bf16(Bt[n][k], At[m][k], acc[ai][bj][m][n], 0, 0, 0); __builtin_amdgcn_s_setprio(0); } while (0)
#define PG8_WAIT_V(n) asm volatile("s_waitcnt vmcnt(" #n ")" ::: "memory")
#define PG8_WAIT_L(n) asm volatile("s_waitcnt lgkmcnt(" #n ")" ::: "memory")
#define PG8_BAR __builtin_amdgcn_s_barrier()
#define PG8_SCHED __builtin_amdgcn_sched_barrier(0)
    Unit cur, nxt; int ui = 0;
    if (!S.next(0, cur)) return;
    f32x4 acc[2][2][4][2];
#pragma unroll
    for (int a = 0; a < 2; ++a)
#pragma unroll
        for (int b = 0; b < 2; ++b)
#pragma unroll
            for (int m = 0; m < 4; ++m)
#pragma unroll
                for (int n = 0; n < 2; ++n) acc[a][b][m][n] = (f32x4){0.f, 0.f, 0.f, 0.f};
    bf16x8 At[4][2], B0[2][2], B1[2][2];
    const char* cA = (const char*)g.A + (size_t)cur.pm * tstep; const char* cB = (const char*)g.Bt + (size_t)cur.pn * tstep;
    S.a_ready(cur);
    if constexpr (SP2) {
        PG8_STAGE(PG8_SB(0, 0), cB, voffB); PG8_STAGE(PG8_SB(0, 1), cB + hstep, voffB); PG8_STAGE(PG8_SA(0, 0), cA, voffA); PG8_STAGE(PG8_SA(0, 1), cA + hstep, voffA);
        if (wr == 1) PG8_BAR;
        PG8_WAIT_V(2); PG8_BAR;
        PG8_STAGE(PG8_SB(1, 0), cB + kstep, voffB); PG8_STAGE(PG8_SA(1, 0), cA + kstep, voffA); PG8_STAGE(PG8_SB(1, 1), cB + hstep + kstep, voffB);
        PG8_WAIT_V(6); PG8_BAR;
    } else {
        PG8_STAGE(PG8_SB(0, 0), cB, voffB); PG8_STAGE(PG8_SA(0, 0), cA, voffA); PG8_STAGE(PG8_SB(0, 1), cB + hstep, voffB); PG8_STAGE(PG8_SA(0, 1), cA + hstep, voffA);
        if (wr == 1) PG8_BAR;
        PG8_WAIT_V(4); PG8_BAR;
        PG8_STAGE(PG8_SB(1, 0), cB + kstep, voffB); PG8_STAGE(PG8_SA(1, 0), cA + kstep, voffA); PG8_STAGE(PG8_SB(1, 1), cB + hstep + kstep, voffB);
        PG8_WAIT_V(6); PG8_BAR;
    }
    for (;;) {
        const bool has_next = S.next(ui + 1, nxt);
        const char* nA = has_next ? (const char*)g.A + (size_t)nxt.pm * tstep : cA; const char* nB = has_next ? (const char*)g.Bt + (size_t)nxt.pn * tstep : cB;
        for (int t = 0; t < nt; t += 2) {
            const bool last = (t == nt - 2);
            const char* a1 = cA + (size_t)(t + 1) * kstep;
            const char* a2 = last ? nA : cA + (size_t)(t + 2) * kstep; const char* b2 = last ? nB : cB + (size_t)(t + 2) * kstep;
            const char* a3 = a2 + kstep; const char* b3 = b2 + kstep;
            if (last && has_next) S.a_ready(nxt);
            if constexpr (SP2) {
            PG8_LDB(B0, 0, 0); PG8_LDB(B1, 0, 1); PG8_SCHED; PG8_LDA(At, 0, 0); PG8_STAGE(PG8_SA(1, 1), a1 + hstep, voffA);
            PG8_WAIT_V(8); PG8_WAIT_L(0); PG8_BAR; PG8_MMA(0, 0, At, B0); PG8_MMA(0, 1, At, B1); PG8_BAR; PG8_SCHED;
            PG8_LDA(At, 0, 1); PG8_STAGE(PG8_SB(0, 0), b2, voffB); PG8_STAGE(PG8_SB(0, 1), b2 + hstep, voffB); PG8_STAGE(PG8_SA(0, 0), a2, voffA);
            PG8_WAIT_V(8); PG8_WAIT_L(0); PG8_BAR; PG8_MMA(1, 0, At, B0); PG8_MMA(1, 1, At, B1); PG8_BAR; PG8_SCHED;
            PG8_LDB(B0, 1, 0); PG8_LDB(B1, 1, 1); PG8_SCHED; PG8_LDA(At, 1, 0); PG8_STAGE(PG8_SA(0, 1), a2 + hstep, voffA);
            PG8_WAIT_V(8); PG8_WAIT_L(0); PG8_BAR; PG8_MMA(0, 0, At, B0); PG8_MMA(0, 1, At, B1); PG8_BAR; PG8_SCHED;
            PG8_LDA(At, 1, 1); PG8_STAGE(PG8_SB(1, 0), b3, voffB); PG8_STAGE(PG8_SB(1, 1), b3 + hstep, voffB); PG8_STAGE(PG8_SA(1, 0), a3, voffA);
            PG8_WAIT_V(8); PG8_WAIT_L(0); PG8_BAR; PG8_MMA(1, 0, At, B0); PG8_MMA(1, 1, At, B1); PG8_BAR; PG8_SCHED;
            } else {
            PG8_LDB(B0, 0, 0); PG8_SCHED; PG8_LDA(At, 0, 0); PG8_STAGE(PG8_SA(1, 1), a1 + hstep, voffA);
            PG8_WAIT_L(8); PG8_BAR; PG8_WAIT_L(0); PG8_MMA(0, 0, At, B0); PG8_BAR; PG8_SCHED;
            PG8_LDB(B1, 0, 1); PG8_STAGE(PG8_SB(0, 0), b2, voffB);
            PG8_BAR; PG8_WAIT_L(0); PG8_MMA(0, 1, At, B1); PG8_BAR;
            PG8_LDA(At, 0, 1); PG8_STAGE(PG8_SA(0, 0), a2, voffA);
            PG8_BAR; PG8_WAIT_L(0); PG8_MMA(1, 0, At, B0); PG8_BAR; PG8_SCHED;
            PG8_STAGE(PG8_SB(0, 1), b2 + hstep, voffB);
            PG8_WAIT_V(6); PG8_BAR; PG8_MMA(1, 1, At, B1); PG8_BAR;
            PG8_LDB(B0, 1, 0); PG8_SCHED; PG8_LDA(At, 1, 0); PG8_STAGE(PG8_SA(0, 1), a2 + hstep, voffA);
            PG8_WAIT_L(8); PG8_BAR; PG8_WAIT_L(0); PG8_MMA(0, 0, At, B0); PG8_BAR; PG8_SCHED;
            PG8_LDB(B1, 1, 1); PG8_STAGE(PG8_SB(1, 0), b3, voffB);
            PG8_BAR; PG8_WAIT_L(0); PG8_MMA(0, 1, At, B1); PG8_BAR;
            PG8_LDA(At, 1, 1); PG8_STAGE(PG8_SA(1, 0), a3, voffA);
            PG8_BAR; PG8_WAIT_L(0); PG8_MMA(1, 0, At, B0); PG8_BAR; PG8_SCHED;
            PG8_STAGE(PG8_SB(1, 1), b3 + hstep, voffB);
            PG8_WAIT_V(6); PG8_BAR; PG8_MMA(1, 1, At, B1); PG8_BAR;
            }
        }
        if constexpr (ALIGN_EPI) { if (wr == 0) PG8_BAR; }
        if constexpr (!Epi::AFTER_DRAIN) { E(acc, cur, wr, wc, fr, fq); S.done(cur); }
        if (!has_next) break;
#pragma unroll
        for (int a = 0; a < 2; ++a)
#pragma unroll
            for (int b = 0; b < 2; ++b)
#pragma unroll
                for (int m = 0; m < 4; ++m)
#pragma unroll
                    for (int n = 0; n < 2; ++n) acc[a][b][m][n] = (f32x4){0.f, 0.f, 0.f, 0.f};
        cur = nxt; cA = nA; cB = nB; ++ui;
        if constexpr (ALIGN_EPI) { if (wr == 1) PG8_BAR; }
    }
    PG8_WAIT_V(0);
    if constexpr (!ALIGN_EPI) { if (wr == 0) PG8_BAR; }
    PG8_BAR;
    if constexpr (Epi::AFTER_DRAIN) { E.fused(acc, cur, wr, wc, fr, fq, lds, wid, lane); S.done(cur); }
#undef PG8_SA
#undef PG8_SB
#undef PG8_STAGE
#undef PG8_LDA
#undef PG8_LDB
#undef PG8_MMA
#undef PG8_WAIT_V
#undef PG8_WAIT_L
#undef PG8_BAR
#undef PG8_SCHED
}
}
#define LAS __attribute__((address_space(3)))
typedef unsigned short bf16;
typedef unsigned v4u __attribute__((ext_vector_type(4)));
typedef unsigned v2u __attribute__((ext_vector_type(2)));
typedef float f32x4 __attribute__((ext_vector_type(4)));
typedef float f32x2 __attribute__((ext_vector_type(2)));
typedef short bf16x8 __attribute__((ext_vector_type(8)));
constexpr int NWAVES = 8, NTHR = 512;
constexpr int BATCH = 16, SEQ = 4096, D = 1024, NMETA = 16, FF = 4096;
constexpr int MR = BATCH * SEQ;
constexpr int META0 = MR;
constexpr int MT = MR + 256;
constexpr int NROWS_LN0 = MR + NMETA;
constexpr int INW = 5640, NIN = 5632;
constexpr int PU = 0, PQ = 512, PK = 1024, PV = 1536, PO = 2560, PGS = 3584, PGM = 4608;
constexpr int IFCOL = 3584;
constexpr int S5G = 32, S5P = 64, S5H = 16, S5W = 512;
constexpr int NCH = 64;
constexpr int MH = 4, DK = 128, DV = 256;
constexpr float LN_EPS = 1e-5f;
constexpr float ALPHA = 1.189207115002721f;

constexpr size_t MiB = 1u << 20;
constexpr size_t WS_CTL = 0, CTL_ZERO_BYTES = 1 * MiB;
constexpr size_t WS_WIN = 2 * MiB, WS_WGLU = 13 * MiB, WS_WMO = 15 * MiB, WS_WO = 17 * MiB, WS_WUP = 19 * MiB, WS_WDN = 27 * MiB;
constexpr size_t WS_SMALL = 35 * MiB;
constexpr size_t WS_KTAB = 36 * MiB;
constexpr size_t WS_M1 = 37 * MiB;
constexpr size_t WS_M2 = 45 * MiB;
constexpr size_t WS_S = 53 * MiB;
constexpr size_t WS_X = 69 * MiB;
constexpr size_t WS_IF = 77 * MiB;
constexpr size_t WS_H0 = 80 * MiB;
constexpr size_t WS_P = 209 * MiB;
constexpr size_t WS_G = 916 * MiB;
constexpr size_t WS_END = 980 * MiB;
constexpr size_t WS_H1 = WS_P;
constexpr size_t WS_V1 = WS_P + 128 * MiB;
constexpr size_t WS_HFF = WS_P + 128 * MiB;
static_assert(WS_H0 + (size_t)MT * D * 2 <= WS_P && WS_P + (size_t)MT * NIN * 2 <= WS_G && WS_G + (size_t)MR * 512 * 2 <= WS_END, "ws map");
static_assert(WS_HFF + (size_t)MR * FF * 2 <= WS_G && WS_IF + (size_t)MT * 8 * 4 <= WS_H0, "ws map 2");
constexpr int LDS_BYTES = 163840;
constexpr int RING_BYTES = 131072;

__device__ __forceinline__ unsigned f2bf(float f) { unsigned u = __builtin_bit_cast(unsigned, f); return (u + 0x7fffu + ((u >> 16) & 1u)) >> 16; }
__device__ __forceinline__ unsigned pk2(float lo, float hi) { return pg8::cvt_pk_bf16(lo, hi); }
__device__ __forceinline__ float bf2f(unsigned short b) { return __uint_as_float(((unsigned)b) << 16); }
__device__ __forceinline__ float bflo(unsigned w) { return __uint_as_float(w << 16); }
__device__ __forceinline__ float bfhi(unsigned w) { return __uint_as_float(w & 0xffff0000u); }
__device__ __forceinline__ float wave_sum(float v) {
#pragma unroll
    for (int o = 1; o < 64; o <<= 1) v += __shfl_xor(v, o);
    return v;
}
__device__ __forceinline__ float sigmf(float x) { return pg8::sigm(x); }
__device__ __forceinline__ float gelu_tanh(float y) { const float z = 0.7978845608028654f * (y + 0.044715f * y * y * y); const float e = __expf(2.f * z); const float th = 1.f - 2.f * __builtin_amdgcn_rcpf(1.f + e); return 0.5f * y * (1.f + th); }
__device__ __forceinline__ float log_sigmoid(float x) { return x >= 0.f ? -log1pf(__expf(-x)) : x - log1pf(__expf(x)); }

struct Args { const float* in[27]; float* out; unsigned char* ws; int ph_lo, ph_hi; };

__device__ __forceinline__ void transpose_item(const float* W, int K, int N, bf16* WT, int dst_r0, int src_c0, int k0, LAS float* scr, int lane) {
#pragma unroll 8
    for (int i = 0; i < 32; ++i) { const int kk = 2 * i + (lane >> 5); scr[kk * 33 + (lane & 31)] = W[(size_t)(k0 + kk) * N + src_c0 + (lane & 31)]; }
    asm volatile("s_waitcnt lgkmcnt(0)" ::: "memory");
    const int c = lane & 7;
#pragma unroll
    for (int j = 0; j < 4; ++j) { const int n = (lane >> 3) + 8 * j; const LAS float* s = scr + (8 * c) * 33 + n;
        v4u o; o.x = pk2(s[0 * 33], s[1 * 33]); o.y = pk2(s[2 * 33], s[3 * 33]); o.z = pk2(s[4 * 33], s[5 * 33]); o.w = pk2(s[6 * 33], s[7 * 33]);
        *(v4u*)(WT + (size_t)(dst_r0 + n) * K + k0 + 8 * c) = o; }
    asm volatile("s_waitcnt lgkmcnt(0)" ::: "memory");
}

__device__ __forceinline__ void s5_table_task(const Args& a, int g, int j, LAS float* scr, int lane) {
    const float* lre = a.in[8]; const float* lim = a.in[9]; const float* ldt = a.in[10]; const float* bre = a.in[11]; const float* bim = a.in[12];
    const float* cre = a.in[13]; const float* cim = a.in[14]; const float* dsk = a.in[15];
    unsigned char* ws = a.ws;
    const int p = lane;
    const double dt = exp((double)ldt[g]);
    const double lr = (double)lre[g * 64 + p], li = (double)lim[g * 64 + p];
    const double zr = lr * dt, zi = li * dt;
    double sn, cs; sincos((double)j * zi, &sn, &cs); const double mag = exp((double)j * zr); const double Er = mag * cs, Ei = mag * sn;
    double s1, c1; sincos(zi, &s1, &c1); const double m1 = exp(zr); const double lbr = m1 * c1, lbi = m1 * s1;
    const double nr = lbr - 1.0, ni = lbi, den = lr * lr + li * li; const double cr = (nr * lr + ni * li) / den, ci = (ni * lr - nr * li) / den;
    const float Fr = (float)(Er * cr - Ei * ci), Fi = (float)(Er * ci + Ei * cr);
    const float Epr = (float)(Er * lbr - Ei * lbi), Epi = (float)(Er * lbi + Ei * lbr);
    { const f32x4* br4 = (const f32x4*)(bre + ((size_t)g * 64 + p) * 16); const f32x4* bi4 = (const f32x4*)(bim + ((size_t)g * 64 + p) * 16);
      bf16* m1r = (bf16*)(ws + WS_M1) + ((size_t)g * 128 + p) * 1024 + (63 - j) * 16; bf16* m1i = m1r + (size_t)64 * 1024;
      f32x2* bbar = (f32x2*)(ws + WS_SMALL + 128 * 1024) + ((size_t)g * 64 + p) * 16;
      unsigned wr[8], wi[8];
#pragma unroll
      for (int q = 0; q < 4; ++q) { const f32x4 br = br4[q], bi = bi4[q]; f32x4 gr, gi;
#pragma unroll
          for (int e = 0; e < 4; ++e) { gr[e] = Fr * br[e] - Fi * bi[e]; gi[e] = Fr * bi[e] + Fi * br[e]; }
          *(LAS f32x4*)(scr + p * 16 + 4 * q) = gr; *(LAS f32x4*)(scr + 1024 + p * 16 + 4 * q) = gi;
          wr[2 * q] = pk2(gr[0], gr[1]); wr[2 * q + 1] = pk2(gr[2], gr[3]); wi[2 * q] = pk2(gi[0], gi[1]); wi[2 * q + 1] = pk2(gi[2], gi[3]);
          if (j == 0) {
#pragma unroll
              for (int e = 0; e < 4; ++e) bbar[4 * q + e] = (f32x2){gr[e], gi[e]}; } }
      *(v4u*)(m1r) = (v4u){wr[0], wr[1], wr[2], wr[3]}; *(v4u*)(m1r + 8) = (v4u){wr[4], wr[5], wr[6], wr[7]};
      *(v4u*)(m1i) = (v4u){wi[0], wi[1], wi[2], wi[3]}; *(v4u*)(m1i + 8) = (v4u){wi[4], wi[5], wi[6], wi[7]}; }
    { bf16* m2 = (bf16*)(ws + WS_M2) + ((size_t)g * 1024 + j * 16) * 128;
#pragma unroll 4
      for (int ho = 0; ho < 16; ++ho) { const float c_r = cre[((size_t)g * 16 + ho) * 64 + p], c_i = cim[((size_t)g * 16 + ho) * 64 + p];
          m2[ho * 128 + p] = (bf16)f2bf(c_r * Epr - c_i * Epi); m2[ho * 128 + 64 + p] = (bf16)f2bf(-(c_r * Epi + c_i * Epr)); } }
    if (j == 0) ((f32x2*)(ws + WS_SMALL + 32 * 1024))[g * 64 + p] = (f32x2){(float)lbr, (float)lbi};
    if (j == 63) ((f32x2*)(ws + WS_SMALL + 64 * 1024))[g * 64 + p] = (f32x2){Epr, Epi};
    asm volatile("s_waitcnt lgkmcnt(0)" ::: "memory");
    { const int ho = lane >> 2, hi0 = (lane & 3) * 4; f32x4 acc = (f32x4){0.f, 0.f, 0.f, 0.f};
      const float* crow = cre + ((size_t)g * 16 + ho) * 64; const float* cirow = cim + ((size_t)g * 16 + ho) * 64;
#pragma unroll 4
      for (int pp = 0; pp < 64; ++pp) { const float c_r = crow[pp], c_i = cirow[pp];
          const f32x4 gr = *(const LAS f32x4*)(scr + pp * 16 + hi0), gi = *(const LAS f32x4*)(scr + 1024 + pp * 16 + hi0);
          acc += gr * c_r - gi * c_i; }
      if (j == 0) {
#pragma unroll
          for (int e = 0; e < 4; ++e) if (ho == hi0 + e) acc[e] += dsk[g * 16 + ho]; }
      bf16* kt = (bf16*)(ws + WS_KTAB) + (((size_t)g * 64 + j) * 16 + ho) * 16 + hi0;
      *(v2u*)kt = (v2u){pk2(acc[0], acc[1]), pk2(acc[2], acc[3])}; }
    asm volatile("s_waitcnt lgkmcnt(0)" ::: "memory");
}

__device__ __forceinline__ void ln0_row(const float* xrow, const float* g0, const float* b0, bf16* orow, float* ifrow, const f32x4 (&wif)[16][2], const float* bif, int lane) {
    const f32x4* xr = (const f32x4*)xrow + lane;
    f32x4 v[4]; float s = 0.f;
#pragma unroll
    for (int j = 0; j < 4; ++j) { v[j] = xr[64 * j]; s += (v[j].x + v[j].y) + (v[j].z + v[j].w); }
    const float mean = wave_sum(s) * (1.f / D); float s2 = 0.f;
#pragma unroll
    for (int j = 0; j < 4; ++j) { v[j] = v[j] - mean; s2 += (v[j].x * v[j].x + v[j].y * v[j].y) + (v[j].z * v[j].z + v[j].w * v[j].w); }
    const float rstd = 1.f / sqrtf(wave_sum(s2) * (1.f / D) + LN_EPS);
    unsigned long long* o8 = (unsigned long long*)orow + lane;
    float pif[8];
#pragma unroll
    for (int c = 0; c < 8; ++c) pif[c] = 0.f;
#pragma unroll
    for (int j = 0; j < 4; ++j) { const f32x4 gg = ((const f32x4*)g0)[lane + 64 * j], bb = ((const f32x4*)b0)[lane + 64 * j];
        const f32x4 y = v[j] * rstd * gg + bb;
        o8[64 * j] = (unsigned long long)pk2(y.x, y.y) | ((unsigned long long)pk2(y.z, y.w) << 32);
#pragma unroll
        for (int e = 0; e < 4; ++e) {
#pragma unroll
            for (int c = 0; c < 4; ++c) { pif[c] += y[e] * wif[4 * j + e][0][c]; pif[4 + c] += y[e] * wif[4 * j + e][1][c]; } } }
#pragma unroll
    for (int c = 0; c < 8; ++c) pif[c] = wave_sum(pif[c]);
    float outv = pif[0];
#pragma unroll
    for (int c = 1; c < 8; ++c) outv = (lane == c) ? pif[c] : outv;
    if (lane < 8) ifrow[lane] = outv + bif[lane];
}

__device__ __forceinline__ void p0_prologue(const Args& a, LAS unsigned char* lds, int vcu, int G, int wave, int lane) {
    unsigned char* ws = a.ws;
    LAS float* scr = (LAS float*)(lds + wave * 16384);
    const int gw = vcu * NWAVES + wave, NGW = G * NWAVES;
    for (int t = gw; t < S5G * 64; t += NGW) s5_table_task(a, t >> 6, t & 63, scr, lane);
    constexpr int I_IN = 16 * (NIN / 32), I_GLU = 8 * 64, I_MO = 16 * 32, I_O = 16 * 32, I_UP = 16 * 128, I_DN = 64 * 32;
    constexpr int NITEMS = I_IN + I_GLU + I_MO + I_O + I_UP + I_DN;
    for (int it = gw; it < NITEMS; it += NGW) {
        int r = it;
        if (r < I_IN) { const int nblk = NIN / 32, kb = r / nblk, nb = r % nblk, dst = 32 * nb; transpose_item(a.in[4], D, INW, (bf16*)(ws + WS_WIN), dst, dst < IFCOL ? dst : dst + 8, 64 * kb, scr, lane); continue; } r -= I_IN;
        if (r < I_GLU) { const int kb = r / 64, nb = r % 64, dst = 32 * nb; const int pn = dst >> 8, half = (dst >> 7) & 1, c = dst & 127;
            transpose_item(a.in[16], S5W, 2 * D, (bf16*)(ws + WS_WGLU), dst, half * D + 128 * pn + c, 64 * kb, scr, lane); continue; } r -= I_GLU;
        if (r < I_MO) { const int kb = r / 32, nb = r % 32; transpose_item(a.in[18], D, D, (bf16*)(ws + WS_WMO), 32 * nb, 32 * nb, 64 * kb, scr, lane); continue; } r -= I_MO;
        if (r < I_O) { const int kb = r / 32, nb = r % 32; transpose_item(a.in[19], D, D, (bf16*)(ws + WS_WO), 32 * nb, 32 * nb, 64 * kb, scr, lane); continue; } r -= I_O;
        if (r < I_UP) { const int kb = r / 128, nb = r % 128; transpose_item(a.in[22], D, FF, (bf16*)(ws + WS_WUP), 32 * nb, 32 * nb, 64 * kb, scr, lane); continue; } r -= I_UP;
        { const int kb = r / 32, nb = r % 32; transpose_item(a.in[24], FF, D, (bf16*)(ws + WS_WDN), 32 * nb, 32 * nb, 64 * kb, scr, lane); }
    }
    { float* bp = (float*)(ws + WS_SMALL); const float* bin = a.in[5];
      for (int i = gw * 64 + lane; i < NIN; i += NGW * 64) bp[i] = bin[i < IFCOL ? i : i + 8]; }
    { f32x4 wif[16][2]; const float* win = a.in[4];
#pragma unroll
      for (int j = 0; j < 4; ++j)
#pragma unroll
          for (int e = 0; e < 4; ++e) { const int k = 4 * lane + 256 * j + e; const f32x4* wp = (const f32x4*)(win + (size_t)k * INW + IFCOL); wif[4 * j + e][0] = wp[0]; wif[4 * j + e][1] = wp[1]; }
      const float* bif = a.in[5] + IFCOL;
      for (int m = gw; m < NROWS_LN0; m += NGW) { const float* xrow = m < MR ? a.in[0] + (size_t)m * D : a.in[1] + (size_t)(m - MR) * D;
          ln0_row(xrow, a.in[2], a.in[3], (bf16*)(ws + WS_H0) + (size_t)m * D, (float*)(ws + WS_IF) + (size_t)m * 8, wif, bif, lane); } }
}

__device__ __forceinline__ void s5a_phase(const Args& a, int vcu, int G, int wave, int lane) {
    unsigned char* ws = a.ws; const int fr = lane & 15, fq = lane >> 4;
    const bf16* P = (const bf16*)(ws + WS_P); const bf16* M1 = (const bf16*)(ws + WS_M1); float* S = (float*)(ws + WS_S);
    for (int it = vcu; it < S5G * 63; it += G) { const int g = it / 63, c = it % 63;
        const bf16* ap = M1 + ((size_t)g * 128 + 16 * wave + fr) * 1024 + 8 * fq;
        const bf16* bp = P + ((size_t)fr * SEQ + 64 * c + (fq >> 1)) * NIN + PU + g * 16 + 8 * (fq & 1);
        f32x4 acc = (f32x4){0.f, 0.f, 0.f, 0.f};
#pragma unroll 8
        for (int kk = 0; kk < 32; ++kk) { const bf16x8 af = *(const bf16x8*)(ap + 32 * kk), bf = *(const bf16x8*)(bp + (size_t)(2 * kk) * NIN);
            acc = __builtin_amdgcn_mfma_f32_16x16x32_bf16(af, bf, acc, 0, 0, 0); }
        *(f32x4*)(S + (((size_t)c * S5G + g) * 16 + fr) * 128 + 16 * wave + 4 * fq) = acc; }
}
__device__ __forceinline__ void s5b_phase(const Args& a, int vcu, int G, int tid) {
    unsigned char* ws = a.ws;
    const bf16* P = (const bf16*)(ws + WS_P); const float* S = (const float*)(ws + WS_S); bf16* XB = (bf16*)(ws + WS_X);
    const f32x2* LB = (const f32x2*)(ws + WS_SMALL + 32 * 1024); const f32x2* LB64 = (const f32x2*)(ws + WS_SMALL + 64 * 1024); const f32x2* BBAR = (const f32x2*)(ws + WS_SMALL + 128 * 1024);
    for (int id = vcu * NTHR + tid; id < S5G * 16 * 64; id += G * NTHR) { const int p = id & 63, b = (id >> 6) & 15, g = id >> 10;
        const f32x2 lb = LB[g * 64 + p], l64 = LB64[g * 64 + p];
        float xr = 0.f, xi = 0.f;
        for (int s = 0; s < NMETA; ++s) { const bf16* up = P + (size_t)(META0 + s) * NIN + PU + g * 16; float br = 0.f, bi = 0.f;
#pragma unroll
            for (int hi = 0; hi < 16; ++hi) { const f32x2 bb = BBAR[((size_t)g * 64 + p) * 16 + hi]; const float u = bf2f(up[hi]); br += bb.x * u; bi += bb.y * u; }
            const float nr = lb.x * xr - lb.y * xi + br, ni = lb.x * xi + lb.y * xr + bi; xr = nr; xi = ni; }
        bf16* xo = XB + (((size_t)0 * S5G + g) * 16 + b) * 128; xo[p] = (bf16)f2bf(xr); xo[64 + p] = (bf16)f2bf(xi);
#pragma unroll 4
        for (int c = 0; c < 63; ++c) { const float* sp = S + (((size_t)c * S5G + g) * 16 + b) * 128; const float sr = sp[p], si = sp[64 + p];
            const float nr = l64.x * xr - l64.y * xi + sr, ni = l64.x * xi + l64.y * xr + si; xr = nr; xi = ni;
            bf16* xo2 = XB + (((size_t)(c + 1) * S5G + g) * 16 + b) * 128; xo2[p] = (bf16)f2bf(xr); xo2[64 + p] = (bf16)f2bf(xi); } }
}
__device__ __forceinline__ void s5c_phase(const Args& a, LAS unsigned char* lds, int vcu, int G, int tid, int wave, int lane) {
    unsigned char* ws = a.ws; const int fr = lane & 15, fq = lane >> 4;
    const bf16* P = (const bf16*)(ws + WS_P); const bf16* M2 = (const bf16*)(ws + WS_M2); const bf16* XB = (const bf16*)(ws + WS_X); const bf16* KTAB = (const bf16*)(ws + WS_KTAB);
    bf16* GO = (bf16*)(ws + WS_G);
    constexpr int KT_BYTES = 65 * 512, U_OFF = KT_BYTES, U_ROW = 2064;
    int gl = -1;
    for (int it = vcu; it < S5G * NCH; it += G) { const int g = it >> 6, c = it & 63;
        __syncthreads();
        if (g != gl) { gl = g;
            for (int i = tid; i < 65 * 32; i += NTHR) { const int e = i >> 5, q = i & 31; v4u v = (v4u){0u, 0u, 0u, 0u}; if (e > 0) v = *(const v4u*)(KTAB + ((size_t)g * 64 + (e - 1)) * 256 + q * 8); *(LAS v4u*)(lds + e * 512 + q * 16) = v; } }
        for (int i = tid; i < 16 * 64 * 2; i += NTHR) { const int hh = i & 1, s = (i >> 1) & 63, b = i >> 7;
            const v4u v = *(const v4u*)(P + ((size_t)b * SEQ + 64 * c + s) * NIN + PU + g * 16 + 8 * hh); *(LAS v4u*)(lds + U_OFF + b * U_ROW + s * 32 + hh * 16) = v; }
        __syncthreads();
        bf16x8 xf[4];
#pragma unroll
        for (int ks = 0; ks < 4; ++ks) xf[ks] = *(const bf16x8*)(XB + (((size_t)c * S5G + g) * 16 + fr) * 128 + 32 * ks + 8 * fq);
        for (int tt = 0; tt < 8; ++tt) { const int t = wave + 8 * tt;
            f32x4 acc = (f32x4){0.f, 0.f, 0.f, 0.f};
            const bf16* m2p = M2 + ((size_t)g * 1024 + t * 16 + fr) * 128 + 8 * fq;
#pragma unroll
            for (int ks = 0; ks < 4; ++ks) acc = __builtin_amdgcn_mfma_f32_16x16x32_bf16(*(const bf16x8*)(m2p + 32 * ks), xf[ks], acc, 0, 0, 0);
            const int nk = (t >> 1) + 1;
            const LAS unsigned char* ab = lds + (t + 1 - (fq >> 1)) * 512 + fr * 32 + (fq & 1) * 16;
            const LAS unsigned char* bb = lds + U_OFF + fr * U_ROW + (fq >> 1) * 32 + (fq & 1) * 16;
            for (int kk = 0; kk < nk; ++kk) { const bf16x8 af = *(const LAS bf16x8*)(ab - kk * 1024), bf = *(const LAS bf16x8*)(bb + kk * 64);
                acc = __builtin_amdgcn_mfma_f32_16x16x32_bf16(af, bf, acc, 0, 0, 0); }
            v2u o; o.x = pk2(gelu_tanh(acc[0]), gelu_tanh(acc[1])); o.y = pk2(gelu_tanh(acc[2]), gelu_tanh(acc[3]));
            *(v2u*)(GO + ((size_t)fr * SEQ + 64 * c + t) * S5W + g * 16 + 4 * fq) = o; }
    }
}

constexpr int QS = 272, VS = 144;
constexpr int ML_Q = 0, ML_K = ML_Q + 64 * QS, ML_VT = ML_K + 64 * QS, ML_KWT = ML_VT + 256 * VS, ML_SP = ML_KWT + 128 * VS, ML_GATE = ML_SP + 64 * VS;
constexpr int ML_A = ML_GATE, ML_MS = ML_GATE + 256, ML_WI = ML_GATE + 512, ML_EM = ML_GATE + 768, ML_WK = ML_GATE + 1024, ML_QN = ML_GATE + 1280, ML_RS = ML_GATE + 1536  ,
              ML_NV = ML_GATE + 2560  , ML_SC = ML_GATE + 3072  , ML_HS = ML_GATE + 3136  , ML_END = ML_HS + 4096;
static_assert(ML_END <= LDS_BYTES - 256, "mlstm lds");

__device__ __forceinline__ void mlstm_chain(const Args& a, LAS unsigned char* lds, int b, int h, int tid, int wave, int lane) {
    unsigned char* ws = a.ws; const int fr = lane & 15, fq = lane >> 4;
    const bf16* P = (const bf16*)(ws + WS_P); const float* IFG = (const float*)(ws + WS_IF);
    bf16* A2 = (bf16*)a.out;
    const float* cw = a.in[6]; const float* cb = a.in[7]; const float* ng = a.in[17];
    LAS float* gA = (LAS float*)(lds + ML_A); LAS float* gMS = (LAS float*)(lds + ML_MS); LAS float* gWI = (LAS float*)(lds + ML_WI); LAS float* gEM = (LAS float*)(lds + ML_EM);
    LAS float* gWK = (LAS float*)(lds + ML_WK); LAS float* gQN = (LAS float*)(lds + ML_QN); LAS float* gRS = (LAS float*)(lds + ML_RS); LAS float* gNV = (LAS float*)(lds + ML_NV);
    LAS float* gSC = (LAS float*)(lds + ML_SC); LAS float* gHS = (LAS float*)(lds + ML_HS);
    f32x4 accC[8][2];
#pragma unroll
    for (int i = 0; i < 8; ++i) { accC[i][0] = (f32x4){0.f, 0.f, 0.f, 0.f}; accC[i][1] = (f32x4){0.f, 0.f, 0.f, 0.f}; }
    __syncthreads();
    if (tid < 128) gNV[tid] = 0.f;
    if (tid == 0) gSC[0] = 0.f;
    __syncthreads();
    const LAS unsigned char* qfrag = lds + ML_Q + fr * QS + fq * 16;
    const LAS unsigned char* kfrag = lds + ML_K + fr * QS + fq * 16;
    const LAS unsigned char* qperm = lds + ML_Q + fr * QS + fq * 8;
    const LAS unsigned char* vfrag = lds + ML_VT + (32 * wave + fr) * VS + fq * 16;
    const LAS unsigned char* kwfrag = lds + ML_KWT + fr * VS + fq * 16;
    const LAS unsigned char* spfrag = lds + ML_SP + fr * VS + fq * 16;
    for (int c = 0; c <= NCH; ++c) {
        if (wave == 0) { const int sp = 64 * c + lane - 48; const bool valid = sp >= 0; const int row = sp < NMETA ? META0 + sp : b * SEQ + (sp - NMETA);
            float li = -INFINITY, lf = 0.f;
            if (valid) { li = IFG[(size_t)row * 8 + h]; lf = log_sigmoid(IFG[(size_t)row * 8 + 4 + h]); }
            float bc = lf;
#pragma unroll
            for (int o = 1; o < 64; o <<= 1) { const float t = __shfl_up(bc, o); if (lane >= o) bc += t; }
            const float av = li - bc; float pm = av;
#pragma unroll
            for (int o = 1; o < 64; o <<= 1) { const float t = __shfl_up(pm, o); if (lane >= o) pm = fmaxf(pm, t); }
            const float mprev = gSC[0]; const float Ms = fmaxf(mprev, pm);
            const float M63 = __shfl(Ms, 63), bl = __shfl(bc, 63);
            gA[lane] = av; gMS[lane] = Ms; gWI[lane] = __expf(mprev - Ms); gEM[lane] = __expf(-(bc + Ms)); gWK[lane] = __expf(av - M63);
            if (lane == 0) { gSC[1] = bl + M63; gSC[2] = __expf(mprev - M63); } }
        __syncthreads();
#pragma unroll 1
        for (int i = tid; i < 2048; i += NTHR) { const int isk = i >> 10, j = (i >> 4) & 63, cg = i & 15; const int sp = 64 * c + j - 48;
            float o8[8];
#pragma unroll
            for (int e = 0; e < 8; ++e) o8[e] = 0.f;
            if (sp >= 0) { const int ch = isk * 512 + h * DK + 8 * cg;
                const f32x4 b0 = *(const f32x4*)(cb + ch), b1 = *(const f32x4*)(cb + ch + 4);
#pragma unroll
                for (int e = 0; e < 4; ++e) { o8[e] = b0[e]; o8[4 + e] = b1[e]; }
#pragma unroll
                for (int w = 0; w < 4; ++w) { const int s2 = sp - 3 + w; if (s2 >= 0) { const int row = s2 < NMETA ? META0 + s2 : b * SEQ + (s2 - NMETA);
                        const v4u x = *(const v4u*)(P + (size_t)row * NIN + PQ + ch); const f32x4 w0 = *(const f32x4*)(cw + w * 1024 + ch), w1 = *(const f32x4*)(cw + w * 1024 + ch + 4);
                        o8[0] += w0[0] * bflo(x.x); o8[1] += w0[1] * bfhi(x.x); o8[2] += w0[2] * bflo(x.y); o8[3] += w0[3] * bfhi(x.y);
                        o8[4] += w1[0] * bflo(x.z); o8[5] += w1[1] * bfhi(x.z); o8[6] += w1[2] * bflo(x.w); o8[7] += w1[3] * bfhi(x.w); } }
                const float sc = isk ? 0.08838834764831845f : 1.f;
#pragma unroll
                for (int e = 0; e < 8; ++e) o8[e] = o8[e] * sigmf(o8[e]) * sc; }
            const v4u pk = (v4u){pk2(o8[0], o8[1]), pk2(o8[2], o8[3]), pk2(o8[4], o8[5]), pk2(o8[6], o8[7])};
            *(LAS v4u*)(lds + (isk ? ML_K : ML_Q) + j * QS + cg * 16) = pk;
            if (isk) { const float wk = gWK[j]; LAS unsigned char* kw = lds + ML_KWT + (8 * cg) * VS + j * 2;
#pragma unroll
                for (int e = 0; e < 8; ++e) *(LAS bf16*)(kw + e * VS) = (bf16)f2bf(o8[e] * wk); } }
#pragma unroll 1
        for (int i = tid; i < 2048; i += NTHR) { const int j = i >> 5, eg = i & 31; const int sp = 64 * c + j - 48;
            v4u x = (v4u){0u, 0u, 0u, 0u};
            if (sp >= 0) { const int row = sp < NMETA ? META0 + sp : b * SEQ + (sp - NMETA); x = *(const v4u*)(P + (size_t)row * NIN + PV + h * DV + 8 * eg); }
            LAS unsigned char* vt = lds + ML_VT + (8 * eg) * VS + j * 2;
            *(LAS bf16*)(vt + 0 * VS) = (bf16)(x.x & 0xffffu); *(LAS bf16*)(vt + 1 * VS) = (bf16)(x.x >> 16); *(LAS bf16*)(vt + 2 * VS) = (bf16)(x.y & 0xffffu); *(LAS bf16*)(vt + 3 * VS) = (bf16)(x.y >> 16);
            *(LAS bf16*)(vt + 4 * VS) = (bf16)(x.z & 0xffffu); *(LAS bf16*)(vt + 5 * VS) = (bf16)(x.z >> 16); *(LAS bf16*)(vt + 6 * VS) = (bf16)(x.w & 0xffffu); *(LAS bf16*)(vt + 7 * VS) = (bf16)(x.w >> 16); }
        __syncthreads();
        if (c > 0) {
#pragma unroll
            for (int i2 = 0; i2 < 2; ++i2) { const int tile = 2 * wave + i2, jt = tile >> 2, st = tile & 3;
                f32x4 acc = (f32x4){0.f, 0.f, 0.f, 0.f};
                if (jt <= st) {
#pragma unroll
                    for (int ks = 0; ks < 4; ++ks) { const bf16x8 af = *(const LAS bf16x8*)(kfrag + jt * 16 * QS + ks * 64), bf = *(const LAS bf16x8*)(qfrag + st * 16 * QS + ks * 64);
                        acc = __builtin_amdgcn_mfma_f32_16x16x32_bf16(af, bf, acc, 0, 0, 0); } }
                const int s = 16 * st + fr, j0 = 16 * jt + 4 * fq; const float Ms = gMS[s]; float rs = 0.f; float sv[4];
#pragma unroll
                for (int r = 0; r < 4; ++r) { const int j = j0 + r; const float w = (j <= s) ? __expf(gA[j] - Ms) : 0.f; sv[r] = acc[r] * w; rs += sv[r]; }
                rs += __shfl_xor(rs, 16); rs += __shfl_xor(rs, 32);
                if (fq == 0) gRS[s * 4 + jt] = rs;
                *(LAS v2u*)(lds + ML_SP + s * VS + j0 * 2) = (v2u){pk2(sv[0], sv[1]), pk2(sv[2], sv[3])}; }
            { const int s = 8 * wave + (lane >> 3), ds = lane & 7; float q = 0.f;
#pragma unroll
              for (int hh = 0; hh < 2; ++hh) { const v4u x = *(const LAS v4u*)(lds + ML_Q + s * QS + (2 * ds + hh) * 16); const LAS float* nv = gNV + 16 * ds + 8 * hh;
                  q += bflo(x.x) * nv[0] + bfhi(x.x) * nv[1] + bflo(x.y) * nv[2] + bfhi(x.y) * nv[3] + bflo(x.z) * nv[4] + bfhi(x.z) * nv[5] + bflo(x.w) * nv[6] + bfhi(x.w) * nv[7]; }
              q += __shfl_xor(q, 1); q += __shfl_xor(q, 2); q += __shfl_xor(q, 4);
              if (ds == 0) gQN[s] = q; }
            __syncthreads();
            f32x4 accN[2][4];
#pragma unroll
            for (int et = 0; et < 2; ++et)
#pragma unroll
                for (int st = 0; st < 4; ++st) accN[et][st] = (f32x4){0.f, 0.f, 0.f, 0.f};
#pragma unroll
            for (int ks = 0; ks < 4; ++ks) { bf16x8 af[2], bf[4];
#pragma unroll
                for (int et = 0; et < 2; ++et) { const f32x4 lo = accC[2 * ks][et], hi4 = accC[2 * ks + 1][et];
                    const v4u w = (v4u){pk2(lo[0], lo[1]), pk2(lo[2], lo[3]), pk2(hi4[0], hi4[1]), pk2(hi4[2], hi4[3])}; af[et] = __builtin_bit_cast(bf16x8, w); }
#pragma unroll
                for (int st = 0; st < 4; ++st) { const v2u l2 = *(const LAS v2u*)(qperm + st * 16 * QS + ks * 64), h2 = *(const LAS v2u*)(qperm + st * 16 * QS + ks * 64 + 32);
                    const v4u w = (v4u){l2.x, l2.y, h2.x, h2.y}; bf[st] = __builtin_bit_cast(bf16x8, w); }
#pragma unroll
                for (int et = 0; et < 2; ++et)
#pragma unroll
                    for (int st = 0; st < 4; ++st) accN[et][st] = __builtin_amdgcn_mfma_f32_16x16x32_bf16(af[et], bf[st], accN[et][st], 0, 0, 0); }
            float dn[4];
#pragma unroll
            for (int st = 0; st < 4; ++st) { const int s = 16 * st + fr; const float wi = gWI[s];
                accN[0][st] = accN[0][st] * wi; accN[1][st] = accN[1][st] * wi;
                const f32x4 rs4 = *(const LAS f32x4*)(gRS + s * 4); const float den = (rs4[0] + rs4[1]) + (rs4[2] + rs4[3]) + wi * gQN[s];
                dn[st] = __builtin_amdgcn_rcpf(fmaxf(fabsf(den), gEM[s])); }
#pragma unroll
            for (int ks = 0; ks < 2; ++ks) { bf16x8 af[2], bf[4];
#pragma unroll
                for (int et = 0; et < 2; ++et) af[et] = *(const LAS bf16x8*)(vfrag + et * 16 * VS + ks * 64);
#pragma unroll
                for (int st = 0; st < 4; ++st) bf[st] = *(const LAS bf16x8*)(spfrag + st * 16 * VS + ks * 64);
#pragma unroll
                for (int et = 0; et < 2; ++et)
#pragma unroll
                    for (int st = 0; st < 4; ++st) accN[et][st] = __builtin_amdgcn_mfma_f32_16x16x32_bf16(af[et], bf[st], accN[et][st], 0, 0, 0); }
#pragma unroll
            for (int st = 0; st < 4; ++st) { float s1 = 0.f, s2 = 0.f;
#pragma unroll
                for (int et = 0; et < 2; ++et) { accN[et][st] = accN[et][st] * dn[st];
#pragma unroll
                    for (int r = 0; r < 4; ++r) { const float v = accN[et][st][r]; s1 += v; s2 += v * v; } }
                s1 += __shfl_xor(s1, 16); s1 += __shfl_xor(s1, 32); s2 += __shfl_xor(s2, 16); s2 += __shfl_xor(s2, 32);
                if (fq == 0) *(LAS f32x2*)(gHS + ((16 * st + fr) * 8 + wave) * 2) = (f32x2){s1, s2}; }
            __syncthreads();
#pragma unroll
            for (int st = 0; st < 4; ++st) { const int s = 16 * st + fr; float s1 = 0.f, s2 = 0.f;
#pragma unroll
                for (int w2 = 0; w2 < 4; ++w2) { const f32x4 t = *(const LAS f32x4*)(gHS + (s * 8 + 2 * w2) * 2); s1 += t[0] + t[2]; s2 += t[1] + t[3]; }
                const float mean = s1 * (1.f / DV), var = fmaxf(s2 * (1.f / DV) - mean * mean, 0.f), rstd = 1.f / sqrtf(var + LN_EPS);
                const size_t row = (size_t)b * SEQ + 64 * (c - 1) + s;
#pragma unroll
                for (int et = 0; et < 2; ++et) { const int e0 = h * DV + 32 * wave + 16 * et + 4 * fq;
                    const v2u so = *(const v2u*)(P + row * NIN + PO + e0); const f32x4 gg = *(const f32x4*)(ng + e0); const f32x4 sof = pg8::bf4f(so.x, so.y);
                    const f32x4 o = (accN[et][st] - mean) * rstd * gg * sof;
                    *(v2u*)(A2 + row * D + e0) = (v2u){pk2(o[0], o[1]), pk2(o[2], o[3])}; } }
        }
        { const float decay = gSC[2];
#pragma unroll
          for (int dt = 0; dt < 8; ++dt) { accC[dt][0] = accC[dt][0] * decay; accC[dt][1] = accC[dt][1] * decay; }
#pragma unroll
          for (int ks = 0; ks < 2; ++ks) { bf16x8 bf[2];
#pragma unroll
              for (int et = 0; et < 2; ++et) bf[et] = *(const LAS bf16x8*)(vfrag + et * 16 * VS + ks * 64);
#pragma unroll
              for (int dt = 0; dt < 8; ++dt) { const bf16x8 af = *(const LAS bf16x8*)(kwfrag + dt * 16 * VS + ks * 64);
                  accC[dt][0] = __builtin_amdgcn_mfma_f32_16x16x32_bf16(af, bf[0], accC[dt][0], 0, 0, 0); accC[dt][1] = __builtin_amdgcn_mfma_f32_16x16x32_bf16(af, bf[1], accC[dt][1], 0, 0, 0); } }
          if (tid < 128) { float nn = gNV[tid] * decay; const LAS unsigned char* kp = lds + ML_K + tid * 2;
#pragma unroll 8
              for (int j = 0; j < 64; ++j) nn += gWK[j] * bf2f(*(const LAS bf16*)(kp + j * QS));
              gNV[tid] = nn; }
          if (tid == 0) gSC[0] = gSC[1]; }
        __syncthreads();
    }
}

template <bool OUT_BF16>
__device__ __forceinline__ void ln_rows(const float* V, const float* g, const float* bta, void* O, int vcu, int G, int wave, int lane) {
    const int gw = vcu * NWAVES + wave, NGW = G * NWAVES;
    f32x4 gg[4], bb[4];
#pragma unroll
    for (int j = 0; j < 4; ++j) { gg[j] = ((const f32x4*)g)[lane + 64 * j]; bb[j] = ((const f32x4*)bta)[lane + 64 * j]; }
    for (int m = gw; m < MR; m += NGW) { const f32x4* xr = (const f32x4*)(V + (size_t)m * D) + lane;
        f32x4 v[4]; float s = 0.f;
#pragma unroll
        for (int j = 0; j < 4; ++j) { v[j] = xr[64 * j]; s += (v[j].x + v[j].y) + (v[j].z + v[j].w); }
        const float mean = wave_sum(s) * (1.f / D); float s2 = 0.f;
#pragma unroll
        for (int j = 0; j < 4; ++j) { v[j] = v[j] - mean; s2 += (v[j].x * v[j].x + v[j].y * v[j].y) + (v[j].z * v[j].z + v[j].w * v[j].w); }
        const float rstd = 1.f / sqrtf(wave_sum(s2) * (1.f / D) + LN_EPS);
#pragma unroll
        for (int j = 0; j < 4; ++j) { const f32x4 y = v[j] * rstd * gg[j] + bb[j];
            if (OUT_BF16) ((unsigned long long*)((bf16*)O + (size_t)m * D))[lane + 64 * j] = (unsigned long long)pk2(y.x, y.y) | ((unsigned long long)pk2(y.z, y.w) << 32);
            else ((f32x4*)((float*)O + (size_t)m * D))[lane + 64 * j] = y; } }
}

#define GAS __attribute__((address_space(1)))
typedef GAS unsigned gu32;
typedef GAS unsigned long long gu64;
#define RLX_AGENT __ATOMIC_RELAXED, __HIP_MEMORY_SCOPE_AGENT
#define LDS_WAIT() asm volatile("s_waitcnt lgkmcnt(0)" ::: "memory")
#define VM_WAIT() asm volatile("s_waitcnt vmcnt(0)" ::: "memory")
__device__ __forceinline__ unsigned long long rt() { return __builtin_amdgcn_s_memrealtime(); }
#define XB_TMO      128
#define XB_XCNT(j)  (256  + 64 * (j))
#define XB_XSUB(j)  (1280 + 64 * (j))
#define XB_XGEN(j)  (2304 + 64 * (j))
#define XB_TOP      3328
#define XB_TOPGEN   3392
#define XCD_BAR_WORDS 3456
#define XB_SPIN_CAP (1u << 18)

__device__ __forceinline__ unsigned xb_ld(unsigned* p)              { return __hip_atomic_load(p, __ATOMIC_RELAXED, __HIP_MEMORY_SCOPE_AGENT); }
__device__ __forceinline__ unsigned xb_add(unsigned* p, unsigned v) { return __hip_atomic_fetch_add(p, v, __ATOMIC_RELAXED, __HIP_MEMORY_SCOPE_AGENT); }
__device__ __forceinline__ unsigned xb_xcc_id() { return (unsigned)__builtin_amdgcn_s_getreg((3 << 11) | 20) & 0xFu; }
#define XB_SPIN(cond, bar) do { unsigned _sp = 0; while (cond) { __builtin_amdgcn_s_sleep(1); \
    if ((++_sp & 255u) == 0u) { if (xb_ld(&(bar)[XB_TMO])) break; if (_sp > XB_SPIN_CAP) { atomicAdd(&(bar)[XB_TMO], 1u); break; } } } } while (0)

struct XcdBarrier {
    unsigned* bar; unsigned x;
    volatile LAS unsigned* st;
};

__device__ __forceinline__ XcdBarrier xcd_barrier_post(unsigned* bar, volatile LAS unsigned* st) {
    XcdBarrier b; b.bar = bar; b.x = xb_xcc_id(); b.st = st;
    if (threadIdx.x == 0) (void)xb_add(&bar[XB_XCNT(b.x)], 1u);
    return b;
}
__device__ __forceinline__ void xcd_barrier_complete(unsigned* bar, unsigned x, unsigned& nloc, unsigned& nx) {
    const unsigned G = gridDim.x * gridDim.y * gridDim.z;
    unsigned sum, cnt, mine, sp = 0u;
    for (;;) {
        sum = 0u; cnt = 0u; mine = 0u;
#pragma unroll
        for (unsigned j = 0; j < 16; ++j) { const unsigned c = xb_ld(&bar[XB_XCNT(j)]); sum += c; cnt += (c > 0u) ? 1u : 0u; mine = (j == x) ? c : mine; }
        if (sum == G) break;
        __builtin_amdgcn_s_sleep(1);
        if ((++sp & 255u) == 0u) { if (xb_ld(&bar[XB_TMO])) break; if (sp > XB_SPIN_CAP) { atomicAdd(&bar[XB_TMO], 1u); break; } }
    }
    nloc = mine > 0u ? mine : 1u; nx = cnt > 0u ? cnt : 1u;
}

__device__ __forceinline__ void xcd_barrier(const XcdBarrier& b) {
    asm volatile("s_waitcnt vmcnt(0)" ::: "memory");
    __syncthreads();
    if (threadIdx.x == 0) {
        unsigned* bar = b.bar;
        __builtin_amdgcn_s_waitcnt(0);
        unsigned nloc = b.st[0], nx = b.st[1];
        if (nloc == 0u) { xcd_barrier_complete(bar, b.x, nloc, nx); b.st[0] = nloc; b.st[1] = nx; }
        const unsigned old = xb_add(&bar[XB_XSUB(b.x)], 1u);
        const unsigned gen = old / nloc;
        if (old + 1u == (gen + 1u) * nloc) {
            __builtin_amdgcn_fence(__ATOMIC_RELEASE, "agent");
            asm volatile("s_waitcnt vmcnt(0)" ::: "memory");
            const unsigned og = xb_add(&bar[XB_TOP], 1u);
            const unsigned tg = og / nx;
            if (og + 1u == (tg + 1u) * nx) xb_add(&bar[XB_TOPGEN], 1u);
            else XB_SPIN(xb_ld(&bar[XB_TOPGEN]) == tg, bar);
            __builtin_amdgcn_fence(__ATOMIC_ACQUIRE, "agent");
            xb_add(&bar[XB_XGEN(b.x)], 1u);
            asm volatile("s_waitcnt vmcnt(0)" ::: "memory");
        } else {
            XB_SPIN(xb_ld(&bar[XB_XGEN(b.x)]) == gen, bar);
            __builtin_amdgcn_fence(__ATOMIC_ACQUIRE, "agent");
            asm volatile("s_waitcnt vmcnt(0)" ::: "memory");
        }
    }
    __syncthreads();
}

constexpr int CW_BAR = 4096;
constexpr int NPHASE = 13;
__global__ void __launch_bounds__(NTHR, 2) fwd_kernel(Args args) {
    extern __shared__ __attribute__((aligned(16))) unsigned char lds_raw[];
    LAS unsigned char* lds = (LAS unsigned char*)lds_raw;
    const int tid = threadIdx.x, lane = tid & 63, wave = __builtin_amdgcn_readfirstlane(tid >> 6);
    const int G = gridDim.x; const int bx = blockIdx.x; const int vcu = (G % 8 == 0) ? (bx % 8) * (G / 8) + bx / 8 : bx;
    unsigned char* ws = args.ws;
    const int lo = args.ph_lo, hi = args.ph_hi;
#define IN(k) (lo <= (k) && (k) < hi)
#define SEAM(k) do { if (IN(k) && IN((k) + 1)) xcd_barrier(bar); } while (0)
    volatile LAS unsigned* MISC = (volatile LAS unsigned*)(lds + LDS_BYTES - 128);
    if (tid < 32) MISC[tid] = 0u;
    __syncthreads();
    XcdBarrier bar; bar.bar = (unsigned*)(ws + WS_CTL) + CW_BAR; bar.x = 0; bar.st = nullptr;
    if (hi - lo > 1) bar = xcd_barrier_post((unsigned*)(ws + WS_CTL) + CW_BAR, MISC + 8);
    if (IN(0)) p0_prologue(args, lds, vcu, G, wave, lane);
    SEAM(0);
    if (IN(1)) { pg8::Gemm g{(const bf16*)(ws + WS_H0), (const bf16*)(ws + WS_WIN), MT, NIN, D}; pg8::StaticOrder S; S.init(MT, NIN, G, bx);
        pg8::EpiIn E{(bf16*)(ws + WS_P), NIN, (const float*)(ws + WS_SMALL), 10};
        pg8::gemm_phase<pg8::EpiIn, pg8::StaticOrder, true, true>(lds, g, S, E); }
    SEAM(1);
    if (IN(2)) s5a_phase(args, vcu, G, wave, lane);
    SEAM(2);
    if (IN(3)) s5b_phase(args, vcu, G, tid);
    SEAM(3);
    if (IN(4)) s5c_phase(args, lds, vcu, G, tid, wave, lane);
    SEAM(4);
    if (IN(5)) { for (int ch = vcu; ch < BATCH * MH; ch += G) mlstm_chain(args, lds, ch >> 2, ch & 3, tid, wave, lane); }
    SEAM(5);
    if (IN(6)) { pg8::Gemm g{(const bf16*)(ws + WS_G), (const bf16*)(ws + WS_WGLU), MR, 2 * D, S5W}; pg8::StaticOrder S; S.init(MR, 2 * D, G, bx);
        pg8::EpiGlu E{(const bf16*)(ws + WS_P) + PGS, NIN, (bf16*)args.out + (size_t)MR * D, D};
        pg8::gemm_phase<pg8::EpiGlu, pg8::StaticOrder, true, true>(lds, g, S, E); }
    SEAM(6);
    if (IN(7)) { pg8::Gemm g{(const bf16*)args.out, (const bf16*)(ws + WS_WMO), MR, D, D}; pg8::StaticOrder S; S.init(MR, D, G, bx);
        pg8::EpiMo E{(const bf16*)(ws + WS_P) + PGM, NIN, (bf16*)args.out + (size_t)MR * D, D};
        pg8::gemm_phase<pg8::EpiMo, pg8::StaticOrder, true, true>(lds, g, S, E); }
    SEAM(7);
    if (IN(8)) { pg8::Gemm g{(const bf16*)args.out + (size_t)MR * D, (const bf16*)(ws + WS_WO), MR, D, D}; pg8::StaticOrder S; S.init(MR, D, G, bx);
        pg8::EpiRes E{(const bf16*)(ws + WS_H0), (float*)(ws + WS_V1), D, ALPHA};
        pg8::gemm_phase<pg8::EpiRes, pg8::StaticOrder, true, true>(lds, g, S, E); }
    SEAM(8);
    if (IN(9)) ln_rows<true>((const float*)(ws + WS_V1), args.in[20], args.in[21], (void*)(ws + WS_H1), vcu, G, wave, lane);
    SEAM(9);
    if (IN(10)) { pg8::Gemm g{(const bf16*)(ws + WS_H1), (const bf16*)(ws + WS_WUP), MR, FF, D}; pg8::StaticOrder S; S.init(MR, FF, G, bx);
        pg8::EpiUp E{(bf16*)(ws + WS_HFF), FF, args.in[23]};
        pg8::gemm_phase<pg8::EpiUp, pg8::StaticOrder, true, true>(lds, g, S, E); }
    SEAM(10);
    if (IN(11)) { pg8::Gemm g{(const bf16*)(ws + WS_HFF), (const bf16*)(ws + WS_WDN), MR, D, FF}; pg8::StaticOrder S; S.init(MR, D, G, bx);
        pg8::EpiRes E{(const bf16*)(ws + WS_H1), args.out, D, ALPHA};
        pg8::gemm_phase<pg8::EpiRes, pg8::StaticOrder, true, true>(lds, g, S, E); }
    SEAM(11);
    if (IN(12)) ln_rows<false>(args.out, args.in[25], args.in[26], (void*)args.out, vcu, G, wave, lane);
#undef SEAM
#undef IN
}

extern "C" void kernel_launch(void* const* d_in, const int* in_sizes, int n_in, void* d_out, int out_size, void* d_ws, size_t ws_size, hipStream_t stream) {
    static int grid = 0;
    if (grid == 0) {
        if (n_in != 27 || in_sizes[0] != MR * D || out_size != MR * D || ws_size < WS_END) { fprintf(stderr, "kernel_launch: unexpected shapes (n_in %d, in0 %d, out %d, ws %zu); nothing launched\n", n_in, n_in > 0 ? in_sizes[0] : -1, out_size, ws_size); grid = -1; return; }
        int dev = 0, cus = 0;
        if (hipGetDevice(&dev) != hipSuccess || hipDeviceGetAttribute(&cus, hipDeviceAttributeMultiprocessorCount, dev) != hipSuccess) { grid = -1; return; }
        if (hipFuncSetAttribute((const void*)fwd_kernel, hipFuncAttributeMaxDynamicSharedMemorySize, LDS_BYTES) != hipSuccess) { fprintf(stderr, "kernel_launch: hipFuncSetAttribute failed\n"); grid = -1; return; }
        (void)hipGetLastError();
        grid = cus;
    }
    if (grid < 0) return;
    Args a{};
    for (int i = 0; i < 27; ++i) a.in[i] = (const float*)d_in[i];
    a.out = (float*)d_out; a.ws = (unsigned char*)d_ws;
#if defined(MK_PER_PHASE)
    for (int ph = 0; ph < NPHASE; ++ph) { a.ph_lo = ph; a.ph_hi = ph + 1;
        hipLaunchKernelGGL(fwd_kernel, dim3(grid), dim3(NTHR), LDS_BYTES, stream, a); }
#else
    if (hipMemsetAsync((char*)d_ws + WS_CTL, 0, CTL_ZERO_BYTES, stream) != hipSuccess) { fprintf(stderr, "kernel_launch: hipMemsetAsync failed\n"); return; }
    a.ph_lo = 0; a.ph_hi = NPHASE;
    hipLaunchKernelGGL(fwd_kernel, dim3(grid), dim3(NTHR), LDS_BYTES, stream, a);
#endif
}
```

```cpp
#include <hip/hip_runtime.h>
#include <cstdio>
#include <cstdint>
namespace pg8 {
#define PG8_LAS __attribute__((address_space(3)))
typedef unsigned short bf16_t;
typedef short bf16x8 __attribute__((ext_vector_type(8)));
typedef float f32x4 __attribute__((ext_vector_type(4)));
typedef unsigned u32x4 __attribute__((ext_vector_type(4)));
constexpr int BM = 256, BK = 64, HALF = 128, HTB = HALF * BK * 2  , STAGE_BYTES = 8 * HTB, NXCD = 8, WGM = 8;

__host__ __device__ __forceinline__ int lds_byte(int r, int c) { const int st = (r >> 4) * 2 + (c >> 5), rr = r & 15, cc = c & 31, ob = rr * 64 + cc * 2; return st * 1024 + (ob ^ (((ob >> 9) & 1) << 5)); }
__host__ __device__ __forceinline__ void stage_rc(int b, int& R, int& C) { const int st = b / 1024, sb = b % 1024, swz = sb ^ (((sb >> 9) & 1) << 5); R = (st >> 1) * 16 + swz / 64; C = (st & 1) * 32 + (swz % 64) / 2; }
__host__ __device__ __forceinline__ int perm32(int rho) { const int n = rho >> 4, i = rho & 15; return 8 * (i >> 2) + 4 * n + (i & 3); }

struct Unit { int pm, pn; };
struct Gemm { const bf16_t* A; const bf16_t* Bt; int M, N, K; };

struct StaticOrder {
    int nM, nN, nwg, G, c;
    __host__ __device__ void init(int M, int N, int G_, int c_) { nM = M / BM; nN = N / BM; nwg = nM * nN; G = G_; c = c_; }
    __host__ __device__ bool next(int i, Unit& u) const {
        const long L = (long)i * G + c; if (L >= nwg) return false;
        int wgid = (int)L; { const int q = nwg / NXCD, r = nwg % NXCD, xcd = wgid % NXCD, off = wgid / NXCD; wgid = (xcd < r ? xcd * (q + 1) : r * (q + 1) + (xcd - r) * q) + off; }
        const int nig = WGM * nN, gid = wgid / nig, fm = gid * WGM, gsz = (nM - fm) < WGM ? (nM - fm) : WGM;
        u.pm = fm + ((wgid % nig) % gsz); u.pn = (wgid % nig) / gsz; return true;
    }
    __device__ __forceinline__ void a_ready(const Unit&) const {}
    __device__ __forceinline__ void done(const Unit&) const {}
};

__device__ __forceinline__ unsigned cvt_pk_bf16(float lo, float hi) { unsigned r; asm volatile("v_cvt_pk_bf16_f32 %0, %1, %2" : "=v"(r) : "v"(lo), "v"(hi)); return r; }
typedef float f32x2 __attribute__((ext_vector_type(2)));
__device__ __forceinline__ float sigm(float x) { return __builtin_amdgcn_rcpf(1.0f + __builtin_amdgcn_exp2f(-1.4426950408889634f * x)); }
__device__ __forceinline__ f32x4 bf4f(unsigned lo, unsigned hi) { return (f32x4){__uint_as_float(lo << 16), __uint_as_float(lo & 0xffff0000u), __uint_as_float(hi << 16), __uint_as_float(hi & 0xffff0000u)}; }
typedef unsigned u32x2 __attribute__((ext_vector_type(2)));

struct EpiIn {
    static constexpr bool PERM = true, AFTER_DRAIN = false;
    bf16_t* P; int ldc; const float* bias; int sig_from;
    __device__ __forceinline__ void operator()(const f32x4 (&acc)[2][2][4][2], const Unit& u, int wr, int wc, int fr, int fq) const {
        const int row0 = u.pm * BM + wr * 64 + fr, col0 = u.pn * BM + wc * 32 + 8 * fq; const bool sg = u.pn >= sig_from;
        f32x4 bv[2][2];
#pragma unroll
        for (int bj = 0; bj < 2; ++bj)
#pragma unroll
            for (int n = 0; n < 2; ++n) bv[bj][n] = *(const f32x4*)(bias + col0 + bj * HALF + 4 * n);
#pragma unroll
        for (int ai = 0; ai < 2; ++ai)
#pragma unroll
            for (int m = 0; m < 4; ++m) { bf16_t* rowp = P + (size_t)(row0 + ai * HALF + m * 16) * ldc + col0;
#pragma unroll
                for (int bj = 0; bj < 2; ++bj) { f32x4 v0 = acc[ai][bj][m][0] + bv[bj][0], v1 = acc[ai][bj][m][1] + bv[bj][1];
                    if (sg) {
#pragma unroll
                        for (int j = 0; j < 4; ++j) { v0[j] = sigm(v0[j]); v1[j] = sigm(v1[j]); } }
                    u32x4 w; w.x = cvt_pk_bf16(v0[0], v0[1]); w.y = cvt_pk_bf16(v0[2], v0[3]); w.z = cvt_pk_bf16(v1[0], v1[1]); w.w = cvt_pk_bf16(v1[2], v1[3]);
                    *(u32x4*)(rowp + bj * HALF) = w; } }
    }
};
struct EpiGlu {
    static constexpr bool PERM = true, AFTER_DRAIN = false;
    const bf16_t* SG; int ldsg; bf16_t* O; int ldo;
    __device__ __forceinline__ void operator()(const f32x4 (&acc)[2][2][4][2], const Unit& u, int wr, int wc, int fr, int fq) const {
        const int row0 = u.pm * BM + wr * 64 + fr, col = u.pn * HALF + wc * 32 + 8 * fq;
#pragma unroll
        for (int ai = 0; ai < 2; ++ai)
#pragma unroll
            for (int m = 0; m < 4; ++m) { const size_t r = (size_t)(row0 + ai * HALF + m * 16);
                const u32x4 s = *(const u32x4*)(SG + r * ldsg + col); const f32x4 s0 = bf4f(s.x, s.y), s1 = bf4f(s.z, s.w);
                f32x4 o0, o1;
#pragma unroll
                for (int j = 0; j < 4; ++j) { o0[j] = s0[j] * acc[ai][0][m][0][j] * sigm(acc[ai][1][m][0][j]); o1[j] = s1[j] * acc[ai][0][m][1][j] * sigm(acc[ai][1][m][1][j]); }
                u32x4 w; w.x = cvt_pk_bf16(o0[0], o0[1]); w.y = cvt_pk_bf16(o0[2], o0[3]); w.z = cvt_pk_bf16(o1[0], o1[1]); w.w = cvt_pk_bf16(o1[2], o1[3]);
                *(u32x4*)(O + r * ldo + col) = w; }
    }
};
struct EpiMo {
    static constexpr bool PERM = true, AFTER_DRAIN = false;
    const bf16_t* SG; int ldsg; bf16_t* O; int ldo;
    __device__ __forceinline__ void operator()(const f32x4 (&acc)[2][2][4][2], const Unit& u, int wr, int wc, int fr, int fq) const {
        const int row0 = u.pm * BM + wr * 64 + fr, col0 = u.pn * BM + wc * 32 + 8 * fq;
#pragma unroll
        for (int ai = 0; ai < 2; ++ai)
#pragma unroll
            for (int m = 0; m < 4; ++m) { const size_t r = (size_t)(row0 + ai * HALF + m * 16);
#pragma unroll
                for (int bj = 0; bj < 2; ++bj) { const int col = col0 + bj * HALF;
                    const u32x4 s = *(const u32x4*)(SG + r * ldsg + col), x = *(const u32x4*)(O + r * ldo + col);
                    const f32x4 o0 = bf4f(x.x, x.y) + bf4f(s.x, s.y) * acc[ai][bj][m][0], o1 = bf4f(x.z, x.w) + bf4f(s.z, s.w) * acc[ai][bj][m][1];
                    u32x4 w; w.x = cvt_pk_bf16(o0[0], o0[1]); w.y = cvt_pk_bf16(o0[2], o0[3]); w.z = cvt_pk_bf16(o1[0], o1[1]); w.w = cvt_pk_bf16(o1[2], o1[3]);
                    *(u32x4*)(O + r * ldo + col) = w; } }
    }
};
struct EpiRes {
    static constexpr bool PERM = false, AFTER_DRAIN = false;
    const bf16_t* R; float* V; int ldc; float alpha;
    __device__ __forceinline__ void operator()(const f32x4 (&acc)[2][2][4][2], const Unit& u, int wr, int wc, int fr, int fq) const {
        const int row0 = u.pm * BM + wr * 64 + fr, col0 = u.pn * BM + wc * 32 + 4 * fq;
#pragma unroll
        for (int ai = 0; ai < 2; ++ai)
#pragma unroll
            for (int m = 0; m < 4; ++m) { const size_t off = (size_t)(row0 + ai * HALF + m * 16) * ldc + col0;
#pragma unroll
                for (int bj = 0; bj < 2; ++bj)
#pragma unroll
                    for (int n = 0; n < 2; ++n) { const u32x2 x = *(const u32x2*)(R + off + bj * HALF + n * 16);
                        *(f32x4*)(V + off + bj * HALF + n * 16) = bf4f(x.x, x.y) * alpha + acc[ai][bj][m][n]; } }
    }
};
struct EpiUp {
    static constexpr bool PERM = true, AFTER_DRAIN = false;
    bf16_t* O; int ldc; const float* bias;
    __device__ __forceinline__ void operator()(const f32x4 (&acc)[2][2][4][2], const Unit& u, int wr, int wc, int fr, int fq) const {
        const int row0 = u.pm * BM + wr * 64 + fr, col0 = u.pn * BM + wc * 32 + 8 * fq;
        f32x4 bv[2][2];
#pragma unroll
        for (int bj = 0; bj < 2; ++bj)
#pragma unroll
            for (int n = 0; n < 2; ++n) bv[bj][n] = *(const f32x4*)(bias + col0 + bj * HALF + 4 * n);
#pragma unroll
        for (int ai = 0; ai < 2; ++ai)
#pragma unroll
            for (int m = 0; m < 4; ++m) { bf16_t* rowp = O + (size_t)(row0 + ai * HALF + m * 16) * ldc + col0;
#pragma unroll
                for (int bj = 0; bj < 2; ++bj) { f32x4 v0 = acc[ai][bj][m][0] + bv[bj][0], v1 = acc[ai][bj][m][1] + bv[bj][1];
#pragma unroll
                    for (int j = 0; j < 4; ++j) { const float a = fmaxf(v0[j], 0.f), b = fmaxf(v1[j], 0.f); v0[j] = a * a; v1[j] = b * b; }
                    u32x4 w; w.x = cvt_pk_bf16(v0[0], v0[1]); w.y = cvt_pk_bf16(v0[2], v0[3]); w.z = cvt_pk_bf16(v1[0], v1[1]); w.w = cvt_pk_bf16(v1[2], v1[3]);
                    *(u32x4*)(rowp + bj * HALF) = w; } }
    }
};
template <class Epi, class Sched, bool ALIGN_EPI = false, bool SP2 = false>
__device__ __forceinline__ void gemm_phase(PG8_LAS unsigned char* lds, const Gemm g, const Sched& S, const Epi& E) {
    const int tid = threadIdx.x, wid = __builtin_amdgcn_readfirstlane(tid >> 6), lane = tid & 63, wr = wid >> 2, wc = wid & 3, fr = lane & 15, fq = lane >> 4;
    const int K = g.K, nt = K / BK;
    unsigned voffA[2], voffB[2];
#pragma unroll
    for (int i = 0; i < 2; ++i) { int R, C; stage_rc(tid * 16 + i * 8192, R, C); const int Rb = Epi::PERM ? ((R & ~31) + perm32(R & 31)) : R;
        voffA[i] = (unsigned)(R * K + C) * 2u; voffB[i] = (unsigned)(Rb * K + C) * 2u; }
    const size_t kstep = (size_t)(BK * 2);
    const size_t hstep = (size_t)HALF * K * 2;
    const size_t tstep = 2 * hstep;
    const unsigned ldsw = (unsigned)wid * 1024u;
    const int aoff = lds_byte(wr * 64 + fr, fq * 8), boff = lds_byte(wc * 32 + fr, fq * 8);
#define PG8_SA(b, h) (((b) * 2 + (h)) * HTB)
#define PG8_SB(b, h) ((4 + (b) * 2 + (h)) * HTB)
#define PG8_STAGE(bufoff, gbase, voff) do { _Pragma("unroll") for (int _i = 0; _i < 2; ++_i) \
        __builtin_amdgcn_global_load_lds((const unsigned*)((const char*)(gbase) + (voff)[_i]), (PG8_LAS unsigned*)(lds + (bufoff) + ldsw + _i * 8192), 16, 0, 0); } while (0)
#define PG8_LDA(dst, b, h) do { _Pragma("unroll") for (int m = 0; m < 4; ++m) _Pragma("unroll") for (int k = 0; k < 2; ++k) dst[m][k] = *(const PG8_LAS bf16x8*)(lds + PG8_SA(b, h) + aoff + m * 2048 + k * 1024); } while (0)
#define PG8_LDB(dst, b, h) do { _Pragma("unroll") for (int n = 0; n < 2; ++n) _Pragma("unroll") for (int k = 0; k < 2; ++k) dst[n][k] = *(const PG8_LAS bf16x8*)(lds + PG8_SB(b, h) + boff + n * 2048 + k * 1024); } while (0)
#define PG8_MMA(ai, bj, At, Bt) do { __builtin_amdgcn_s_setprio(1); _Pragma("unroll") for (int m = 0; m < 4; ++m) _Pragma("unroll") for (int n = 0; n < 2; ++n) _Pragma("unroll") for (int k = 0; k < 2; ++k) \
        acc[ai][bj][m][n] = __builtin_amdgcn_mfma_f32_16x16x32_bf16(Bt[n][k], At[m][k], acc[ai][bj][m][n], 0, 0, 0); __builtin_amdgcn_s_setprio(0); } while (0)
#define PG8_WAIT_V(n) asm volatile("s_waitcnt vmcnt(" #n ")" ::: "memory")
#define PG8_WAIT_L(n) asm volatile("s_waitcnt lgkmcnt(" #n ")" ::: "memory")
#define PG8_BAR __builtin_amdgcn_s_barrier()
#define PG8_SCHED __builtin_amdgcn_sched_barrier(0)
    Unit cur, nxt; int ui = 0;
    if (!S.next(0, cur)) return;
    f32x4 acc[2][2][4][2];
#pragma unroll
    for (int a = 0; a < 2; ++a)
#pragma unroll
        for (int b = 0; b < 2; ++b)
#pragma unroll
            for (int m = 0; m < 4; ++m)
#pragma unroll
                for (int n = 0; n < 2; ++n) acc[a][b][m][n] = (f32x4){0.f, 0.f, 0.f, 0.f};
    bf16x8 At[4][2], B0[2][2], B1[2][2];
    const char* cA = (const char*)g.A + (size_t)cur.pm * tstep; const char* cB = (const char*)g.Bt + (size_t)cur.pn * tstep;
    S.a_ready(cur);
    if constexpr (SP2) {
        PG8_STAGE(PG8_SB(0, 0), cB, voffB); PG8_STAGE(PG8_SB(0, 1), cB + hstep, voffB); PG8_STAGE(PG8_SA(0, 0), cA, voffA); PG8_STAGE(PG8_SA(0, 1), cA + hstep, voffA);
        if (wr == 1) PG8_BAR;
        PG8_WAIT_V(2); PG8_BAR;
        PG8_STAGE(PG8_SB(1, 0), cB + kstep, voffB); PG8_STAGE(PG8_SA(1, 0), cA + kstep, voffA); PG8_STAGE(PG8_SB(1, 1), cB + hstep + kstep, voffB);
        PG8_WAIT_V(6); PG8_BAR;
    } else {
        PG8_STAGE(PG8_SB(0, 0), cB, voffB); PG8_STAGE(PG8_SA(0, 0), cA, voffA); PG8_STAGE(PG8_SB(0, 1), cB + hstep, voffB); PG8_STAGE(PG8_SA(0, 1), cA + hstep, voffA);
        if (wr == 1) PG8_BAR;
        PG8_WAIT_V(4); PG8_BAR;
        PG8_STAGE(PG8_SB(1, 0), cB + kstep, voffB); PG8_STAGE(PG8_SA(1, 0), cA + kstep, voffA); PG8_STAGE(PG8_SB(1, 1), cB + hstep + kstep, voffB);
        PG8_WAIT_V(6); PG8_BAR;
    }
    for (;;) {
        const bool has_next = S.next(ui + 1, nxt);
        const char* nA = has_next ? (const char*)g.A + (size_t)nxt.pm * tstep : cA; const char* nB = has_next ? (const char*)g.Bt + (size_t)nxt.pn * tstep : cB;
        for (int t = 0; t < nt; t += 2) {
            const bool last = (t == nt - 2);
            const char* a1 = cA + (size_t)(t + 1) * kstep;
            const char* a2 = last ? nA : cA + (size_t)(t + 2) * kstep; const char* b2 = last ? nB : cB + (size_t)(t + 2) * kstep;
            const char* a3 = a2 + kstep; const char* b3 = b2 + kstep;
            if (last && has_next) S.a_ready(nxt);
            if constexpr (SP2) {
            PG8_LDB(B0, 0, 0); PG8_LDB(B1, 0, 1); PG8_SCHED; PG8_LDA(At, 0, 0); PG8_STAGE(PG8_SA(1, 1), a1 + hstep, voffA);
            PG8_WAIT_V(8); PG8_WAIT_L(0); PG8_BAR; PG8_MMA(0, 0, At, B0); PG8_MMA(0, 1, At, B1); PG8_BAR; PG8_SCHED;
            PG8_LDA(At, 0, 1); PG8_STAGE(PG8_SB(0, 0), b2, voffB); PG8_STAGE(PG8_SB(0, 1), b2 + hstep, voffB); PG8_STAGE(PG8_SA(0, 0), a2, voffA);
            PG8_WAIT_V(8); PG8_WAIT_L(0); PG8_BAR; PG8_MMA(1, 0, At, B0); PG8_MMA(1, 1, At, B1); PG8_BAR; PG8_SCHED;
            PG8_LDB(B0, 1, 0); PG8_LDB(B1, 1, 1); PG8_SCHED; PG8_LDA(At, 1, 0); PG8_STAGE(PG8_SA(0, 1), a2 + hstep, voffA);
            PG8_WAIT_V(8); PG8_WAIT_L(0); PG8_BAR; PG8_MMA(0, 0, At, B0); PG8_MMA(0, 1, At, B1); PG8_BAR; PG8_SCHED;
            PG8_LDA(At, 1, 1); PG8_STAGE(PG8_SB(1, 0), b3, voffB); PG8_STAGE(PG8_SB(1, 1), b3 + hstep, voffB); PG8_STAGE(PG8_SA(1, 0), a3, voffA);
            PG8_WAIT_V(8); PG8_WAIT_L(0); PG8_BAR; PG8_MMA(1, 0, At, B0); PG8_MMA(1, 1, At, B1); PG8_BAR; PG8_SCHED;
            } else {
            PG8_LDB(B0, 0, 0); PG8_SCHED; PG8_LDA(At, 0, 0); PG8_STAGE(PG8_SA(1, 1), a1 + hstep, voffA);
            PG8_WAIT_L(8); PG8_BAR; PG8_WAIT_L(0); PG8_MMA(0, 0, At, B0); PG8_BAR; PG8_SCHED;
            PG8_LDB(B1, 0, 1); PG8_STAGE(PG8_SB(0, 0), b2, voffB);
            PG8_BAR; PG8_WAIT_L(0); PG8_MMA(0, 1, At, B1); PG8_BAR;
            PG8_LDA(At, 0, 1); PG8_STAGE(PG8_SA(0, 0), a2, voffA);
            PG8_BAR; PG8_WAIT_L(0); PG8_MMA(1, 0, At, B0); PG8_BAR; PG8_SCHED;
            PG8_STAGE(PG8_SB(0, 1), b2 + hstep, voffB);
            PG8_WAIT_V(6); PG8_BAR; PG8_MMA(1, 1, At, B1); PG8_BAR;
            PG8_LDB(B0, 1, 0); PG8_SCHED; PG8_LDA(At, 1, 0); PG8_STAGE(PG8_SA(0, 1), a2 + hstep, voffA);
            PG8_WAIT_L(8); PG8_BAR; PG8_WAIT_L(0); PG8_MMA(0, 0, At, B0); PG8_BAR; PG8_SCHED;
            PG8_LDB(B1, 1, 1); PG8_STAGE(PG8_SB(1, 0), b3, voffB);
            PG8_BAR; PG8_WAIT_L(0); PG8_MMA(0, 1, At, B1); PG8_BAR;
            PG8_LDA(At, 1, 1); PG8_STAGE(PG8_SA(1, 0), a3, voffA);
            PG8_BAR; PG8_WAIT_L(0); PG8_MMA(1, 0, At, B0); PG8_BAR; PG8_SCHED;
            PG8_STAGE(PG8_SB(1, 1), b3 + hstep, voffB);
            PG8_WAIT_V(6); PG8_BAR; PG8_MMA(1, 1, At, B1); PG8_BAR;
            }
        }
        if constexpr (ALIGN_EPI) { if (wr == 0) PG8_BAR; }
        if constexpr (!Epi::AFTER_DRAIN) { E(acc, cur, wr, wc, fr, fq); S.done(cur); }
        if (!has_next) break;
#pragma unroll
        for (int a = 0; a < 2; ++a)
#pragma unroll
            for (int b = 0; b < 2; ++b)
#pragma unroll
                for (int m = 0; m < 4; ++m)
#pragma unroll
                    for (int n = 0; n < 2; ++n) acc[a][b][m][n] = (f32x4){0.f, 0.f, 0.f, 0.f};
        cur = nxt; cA = nA; cB = nB; ++ui;
        if constexpr (ALIGN_EPI) { if (wr == 1) PG8_BAR; }
    }
    PG8_WAIT_V(0);
    if constexpr (!ALIGN_EPI) { if (wr == 0) PG8_BAR; }
    PG8_BAR;
    if constexpr (Epi::AFTER_DRAIN) { E.fused(acc, cur, wr, wc, fr, fq, lds, wid, lane); S.done(cur); }
#undef PG8_SA
#undef PG8_SB
#undef PG8_STAGE
#undef PG8_LDA
#undef PG8_LDB
#undef PG8_MMA
#undef PG8_WAIT_V
#undef PG8_WAIT_L
#undef PG8_BAR
#undef PG8_SCHED
}
}
#define LAS __attribute__((address_space(3)))
typedef unsigned short bf16;
typedef unsigned v4u __attribute__((ext_vector_type(4)));
typedef unsigned v2u __attribute__((ext_vector_type(2)));
typedef float f32x4 __attribute__((ext_vector_type(4)));
typedef float f32x2 __attribute__((ext_vector_type(2)));
typedef short bf16x8 __attribute__((ext_vector_type(8)));
constexpr int NWAVES = 8, NTHR = 512;
constexpr int BATCH = 16, SEQ = 4096, D = 1024, NMETA = 16, FF = 4096;
constexpr int MR = BATCH * SEQ;
constexpr int META0 = MR;
constexpr int MT = MR + 256;
constexpr int NROWS_LN0 = MR + NMETA;
constexpr int INW = 5640, NIN = 5632;
constexpr int PU = 0, PQ = 512, PK = 1024, PV = 1536, PO = 2560, PGS = 3584, PGM = 4608;
constexpr int IFCOL = 3584;
constexpr int S5G = 32, S5P = 64, S5H = 16, S5W = 512;
constexpr int NCH = 64;
constexpr int MH = 4, DK = 128, DV = 256;
constexpr float LN_EPS = 1e-5f;
constexpr float ALPHA = 1.189207115002721f;

constexpr size_t MiB = 1u << 20;
constexpr size_t WS_CTL = 0, CTL_ZERO_BYTES = 1 * MiB;
constexpr size_t WS_WIN = 2 * MiB, WS_WGLU = 13 * MiB, WS_WMO = 15 * MiB, WS_WO = 17 * MiB, WS_WUP = 19 * MiB, WS_WDN = 27 * MiB;
constexpr size_t WS_SMALL = 35 * MiB;
constexpr size_t WS_KTAB = 36 * MiB;
constexpr size_t WS_M1 = 37 * MiB;
constexpr size_t WS_M2 = 45 * MiB;
constexpr size_t WS_S = 53 * MiB;
constexpr size_t WS_X = 69 * MiB;
constexpr size_t WS_IF = 77 * MiB;
constexpr size_t WS_H0 = 80 * MiB;
constexpr size_t WS_P = 209 * MiB;
constexpr size_t WS_G = 916 * MiB;
constexpr size_t WS_END = 980 * MiB;
constexpr size_t WS_H1 = WS_P;
constexpr size_t WS_V1 = WS_P + 128 * MiB;
constexpr size_t WS_HFF = WS_P + 128 * MiB;
static_assert(WS_H0 + (size_t)MT * D * 2 <= WS_P && WS_P + (size_t)MT * NIN * 2 <= WS_G && WS_G + (size_t)MR * 512 * 2 <= WS_END, "ws map");
static_assert(WS_HFF + (size_t)MR * FF * 2 <= WS_G && WS_IF + (size_t)MT * 8 * 4 <= WS_H0, "ws map 2");
constexpr int LDS_BYTES = 163840;
constexpr int RING_BYTES = 131072;

__device__ __forceinline__ unsigned f2bf(float f) { unsigned u = __builtin_bit_cast(unsigned, f); return (u + 0x7fffu + ((u >> 16) & 1u)) >> 16; }
__device__ __forceinline__ unsigned pk2(float lo, float hi) { return pg8::cvt_pk_bf16(lo, hi); }
__device__ __forceinline__ float bf2f(unsigned short b) { return __uint_as_float(((unsigned)b) << 16); }
__device__ __forceinline__ float bflo(unsigned w) { return __uint_as_float(w << 16); }
__device__ __forceinline__ float bfhi(unsigned w) { return __uint_as_float(w & 0xffff0000u); }
__device__ __forceinline__ float wave_sum(float v) {
#pragma unroll
    for (int o = 1; o < 64; o <<= 1) v += __shfl_xor(v, o);
    return v;
}
__device__ __forceinline__ float sigmf(float x) { return pg8::sigm(x); }
__device__ __forceinline__ float gelu_tanh(float y) { const float z = 0.7978845608028654f * (y + 0.044715f * y * y * y); const float e = __expf(2.f * z); const float th = 1.f - 2.f * __builtin_amdgcn_rcpf(1.f + e); return 0.5f * y * (1.f + th); }
__device__ __forceinline__ float log_sigmoid(float x) { return x >= 0.f ? -log1pf(__expf(-x)) : x - log1pf(__expf(x)); }

struct Args { const float* in[27]; float* out; unsigned char* ws; int ph_lo, ph_hi; };

__device__ __forceinline__ void transpose_item(const float* W, int K, int N, bf16* WT, int dst_r0, int src_c0, int k0, LAS float* scr, int lane) {
#pragma unroll 8
    for (int i = 0; i < 32; ++i) { const int kk = 2 * i + (lane >> 5); scr[kk * 33 + (lane & 31)] = W[(size_t)(k0 + kk) * N + src_c0 + (lane & 31)]; }
    asm volatile("s_waitcnt lgkmcnt(0)" ::: "memory");
    const int c = lane & 7;
#pragma unroll
    for (int j = 0; j < 4; ++j) { const int n = (lane >> 3) + 8 * j; const LAS float* s = scr + (8 * c) * 33 + n;
        v4u o; o.x = pk2(s[0 * 33], s[1 * 33]); o.y = pk2(s[2 * 33], s[3 * 33]); o.z = pk2(s[4 * 33], s[5 * 33]); o.w = pk2(s[6 * 33], s[7 * 33]);
        *(v4u*)(WT + (size_t)(dst_r0 + n) * K + k0 + 8 * c) = o; }
    asm volatile("s_waitcnt lgkmcnt(0)" ::: "memory");
}

__device__ __forceinline__ void s5_table_task(const Args& a, int g, int j, LAS float* scr, int lane) {
    const float* lre = a.in[8]; const float* lim = a.in[9]; const float* ldt = a.in[10]; const float* bre = a.in[11]; const float* bim = a.in[12];
    const float* cre = a.in[13]; const float* cim = a.in[14]; const float* dsk = a.in[15];
    unsigned char* ws = a.ws;
    const int p = lane;
    const double dt = exp((double)ldt[g]);
    const double lr = (double)lre[g * 64 + p], li = (double)lim[g * 64 + p];
    const double zr = lr * dt, zi = li * dt;
    double sn, cs; sincos((double)j * zi, &sn, &cs); const double mag = exp((double)j * zr); const double Er = mag * cs, Ei = mag * sn;
    double s1, c1; sincos(zi, &s1, &c1); const double m1 = exp(zr); const double lbr = m1 * c1, lbi = m1 * s1;
    const double nr = lbr - 1.0, ni = lbi, den = lr * lr + li * li; const double cr = (nr * lr + ni * li) / den, ci = (ni * lr - nr * li) / den;
    const float Fr = (float)(Er * cr - Ei * ci), Fi = (float)(Er * ci + Ei * cr);
    const float Epr = (float)(Er * lbr - Ei * lbi), Epi = (float)(Er * lbi + Ei * lbr);
    { const f32x4* br4 = (const f32x4*)(bre + ((size_t)g * 64 + p) * 16); const f32x4* bi4 = (const f32x4*)(bim + ((size_t)g * 64 + p) * 16);
      bf16* m1r = (bf16*)(ws + WS_M1) + ((size_t)g * 128 + p) * 1024 + (63 - j) * 16; bf16* m1i = m1r + (size_t)64 * 1024;
      f32x2* bbar = (f32x2*)(ws + WS_SMALL + 128 * 1024) + ((size_t)g * 64 + p) * 16;
      unsigned wr[8], wi[8];
#pragma unroll
      for (int q = 0; q < 4; ++q) { const f32x4 br = br4[q], bi = bi4[q]; f32x4 gr, gi;
#pragma unroll
          for (int e = 0; e < 4; ++e) { gr[e] = Fr * br[e] - Fi * bi[e]; gi[e] = Fr * bi[e] + Fi * br[e]; }
          *(LAS f32x4*)(scr + p * 16 + 4 * q) = gr; *(LAS f32x4*)(scr + 1024 + p * 16 + 4 * q) = gi;
          wr[2 * q] = pk2(gr[0], gr[1]); wr[2 * q + 1] = pk2(gr[2], gr[3]); wi[2 * q] = pk2(gi[0], gi[1]); wi[2 * q + 1] = pk2(gi[2], gi[3]);
          if (j == 0) {
#pragma unroll
              for (int e = 0; e < 4; ++e) bbar[4 * q + e] = (f32x2){gr[e], gi[e]}; } }
      *(v4u*)(m1r) = (v4u){wr[0], wr[1], wr[2], wr[3]}; *(v4u*)(m1r + 8) = (v4u){wr[4], wr[5], wr[6], wr[7]};
      *(v4u*)(m1i) = (v4u){wi[0], wi[1], wi[2], wi[3]}; *(v4u*)(m1i + 8) = (v4u){wi[4], wi[5], wi[6], wi[7]}; }
    { bf16* m2 = (bf16*)(ws + WS_M2) + ((size_t)g * 1024 + j * 16) * 128;
#pragma unroll 4
      for (int ho = 0; ho < 16; ++ho) { const float c_r = cre[((size_t)g * 16 + ho) * 64 + p], c_i = cim[((size_t)g * 16 + ho) * 64 + p];
          m2[ho * 128 + p] = (bf16)f2bf(c_r * Epr - c_i * Epi); m2[ho * 128 + 64 + p] = (bf16)f2bf(-(c_r * Epi + c_i * Epr)); } }
    if (j == 0) ((f32x2*)(ws + WS_SMALL + 32 * 1024))[g * 64 + p] = (f32x2){(float)lbr, (float)lbi};
    if (j == 63) ((f32x2*)(ws + WS_SMALL + 64 * 1024))[g * 64 + p] = (f32x2){Epr, Epi};
    asm volatile("s_waitcnt lgkmcnt(0)" ::: "memory");
    { const int ho = lane >> 2, hi0 = (lane & 3) * 4; f32x4 acc = (f32x4){0.f, 0.f, 0.f, 0.f};
      const float* crow = cre + ((size_t)g * 16 + ho) * 64; const float* cirow = cim + ((size_t)g * 16 + ho) * 64;
#pragma unroll 4
      for (int pp = 0; pp < 64; ++pp) { const float c_r = crow[pp], c_i = cirow[pp];
          const f32x4 gr = *(const LAS f32x4*)(scr + pp * 16 + hi0), gi = *(const LAS f32x4*)(scr + 1024 + pp * 16 + hi0);
          acc += gr * c_r - gi * c_i; }
      if (j == 0) {
#pragma unroll
          for (int e = 0; e < 4; ++e) if (ho == hi0 + e) acc[e] += dsk[g * 16 + ho]; }
      bf16* kt = (bf16*)(ws + WS_KTAB) + (((size_t)g * 64 + j) * 16 + ho) * 16 + hi0;
      *(v2u*)kt = (v2u){pk2(acc[0], acc[1]), pk2(acc[2], acc[3])}; }
    asm volatile("s_waitcnt lgkmcnt(0)" ::: "memory");
}

__device__ __forceinline__ void ln0_row(const float* xrow, const float* g0, const float* b0, bf16* orow, float* ifrow, const f32x4 (&wif)[16][2], const float* bif, int lane) {
    const f32x4* xr = (const f32x4*)xrow + lane;
    f32x4 v[4]; float s = 0.f;
#pragma unroll
    for (int j = 0; j < 4; ++j) { v[j] = xr[64 * j]; s += (v[j].x + v[j].y) + (v[j].z + v[j].w); }
    const float mean = wave_sum(s) * (1.f / D); float s2 = 0.f;
#pragma unroll
    for (int j = 0; j < 4; ++j) { v[j] = v[j] - mean; s2 += (v[j].x * v[j].x + v[j].y * v[j].y) + (v[j].z * v[j].z + v[j].w * v[j].w); }
    const float rstd = 1.f / sqrtf(wave_sum(s2) * (1.f / D) + LN_EPS);
    unsigned long long* o8 = (unsigned long long*)orow + lane;
    float pif[8];
#pragma unroll
    for (int c = 0; c < 8; ++c) pif[c] = 0.f;
#pragma unroll
    for (int j = 0; j < 4; ++j) { const f32x4 gg = ((const f32x4*)g0)[lane + 64 * j], bb = ((const f32x4*)b0)[lane + 64 * j];
        const f32x4 y = v[j] * rstd * gg + bb;
        o8[64 * j] = (unsigned long long)pk2(y.x, y.y) | ((unsigned long long)pk2(y.z, y.w) << 32);
#pragma unroll
        for (int e = 0; e < 4; ++e) {
#pragma unroll
            for (int c = 0; c < 4; ++c) { pif[c] += y[e] * wif[4 * j + e][0][c]; pif[4 + c] += y[e] * wif[4 * j + e][1][c]; } } }
#pragma unroll
    for (int c = 0; c < 8; ++c) pif[c] = wave_sum(pif[c]);
    float outv = pif[0];
#pragma unroll
    for (int c = 1; c < 8; ++c) outv = (lane == c) ? pif[c] : outv;
    if (lane < 8) ifrow[lane] = outv + bif[lane];
}

__device__ __forceinline__ void p0_prologue(const Args& a, LAS unsigned char* lds, int vcu, int G, int wave, int lane) {
    unsigned char* ws = a.ws;
    LAS float* scr = (LAS float*)(lds + wave * 16384);
    const int gw = vcu * NWAVES + wave, NGW = G * NWAVES;
    for (int t = gw; t < S5G * 64; t += NGW) s5_table_task(a, t >> 6, t & 63, scr, lane);
    constexpr int I_IN = 16 * (NIN / 32), I_GLU = 8 * 64, I_MO = 16 * 32, I_O = 16 * 32, I_UP = 16 * 128, I_DN = 64 * 32;
    constexpr int NITEMS = I_IN + I_GLU + I_MO + I_O + I_UP + I_DN;
    for (int it = gw; it < NITEMS; it += NGW) {
        int r = it;
        if (r < I_IN) { const int nblk = NIN / 32, kb = r / nblk, nb = r % nblk, dst = 32 * nb; transpose_item(a.in[4], D, INW, (bf16*)(ws + WS_WIN), dst, dst < IFCOL ? dst : dst + 8, 64 * kb, scr, lane); continue; } r -= I_IN;
        if (r < I_GLU) { const int kb = r / 64, nb = r % 64, dst = 32 * nb; const int pn = dst >> 8, half = (dst >> 7) & 1, c = dst & 127;
            transpose_item(a.in[16], S5W, 2 * D, (bf16*)(ws + WS_WGLU), dst, half * D + 128 * pn + c, 64 * kb, scr, lane); continue; } r -= I_GLU;
        if (r < I_MO) { const int kb = r / 32, nb = r % 32; transpose_item(a.in[18], D, D, (bf16*)(ws + WS_WMO), 32 * nb, 32 * nb, 64 * kb, scr, lane); continue; } r -= I_MO;
        if (r < I_O) { const int kb = r / 32, nb = r % 32; transpose_item(a.in[19], D, D, (bf16*)(ws + WS_WO), 32 * nb, 32 * nb, 64 * kb, scr, lane); continue; } r -= I_O;
        if (r < I_UP) { const int kb = r / 128, nb = r % 128; transpose_item(a.in[22], D, FF, (bf16*)(ws + WS_WUP), 32 * nb, 32 * nb, 64 * kb, scr, lane); continue; } r -= I_UP;
        { const int kb = r / 32, nb = r % 32; transpose_item(a.in[24], FF, D, (bf16*)(ws + WS_WDN), 32 * nb, 32 * nb, 64 * kb, scr, lane); }
    }
    { float* bp = (float*)(ws + WS_SMALL); const float* bin = a.in[5];
      for (int i = gw * 64 + lane; i < NIN; i += NGW * 64) bp[i] = bin[i < IFCOL ? i : i + 8]; }
    { f32x4 wif[16][2]; const float* win = a.in[4];
#pragma unroll
      for (int j = 0; j < 4; ++j)
#pragma unroll
          for (int e = 0; e < 4; ++e) { const int k = 4 * lane + 256 * j + e; const f32x4* wp = (const f32x4*)(win + (size_t)k * INW + IFCOL); wif[4 * j + e][0] = wp[0]; wif[4 * j + e][1] = wp[1]; }
      const float* bif = a.in[5] + IFCOL;
      for (int m = gw; m < NROWS_LN0; m += NGW) { const float* xrow = m < MR ? a.in[0] + (size_t)m * D : a.in[1] + (size_t)(m - MR) * D;
          ln0_row(xrow, a.in[2], a.in[3], (bf16*)(ws + WS_H0) + (size_t)m * D, (float*)(ws + WS_IF) + (size_t)m * 8, wif, bif, lane); } }
}

__device__ __forceinline__ void s5a_phase(const Args& a, int vcu, int G, int wave, int lane) {
    unsigned char* ws = a.ws; const int fr = lane & 15, fq = lane >> 4;
    const bf16* P = (const bf16*)(ws + WS_P); const bf16* M1 = (const bf16*)(ws + WS_M1); float* S = (float*)(ws + WS_S);
    for (int it = vcu; it < S5G * 63; it += G) { const int g = it / 63, c = it % 63;
        const bf16* ap = M1 + ((size_t)g * 128 + 16 * wave + fr) * 1024 + 8 * fq;
        const bf16* bp = P + ((size_t)fr * SEQ + 64 * c + (fq >> 1)) * NIN + PU + g * 16 + 8 * (fq & 1);
        f32x4 acc = (f32x4){0.f, 0.f, 0.f, 0.f};
#pragma unroll 8
        for (int kk = 0; kk < 32; ++kk) { const bf16x8 af = *(const bf16x8*)(ap + 32 * kk), bf = *(const bf16x8*)(bp + (size_t)(2 * kk) * NIN);
            acc = __builtin_amdgcn_mfma_f32_16x16x32_bf16(af, bf, acc, 0, 0, 0); }
        *(f32x4*)(S + (((size_t)c * S5G + g) * 16 + fr) * 128 + 16 * wave + 4 * fq) = acc; }
}
__device__ __forceinline__ void s5b_phase(const Args& a, int vcu, int G, int tid) {
    unsigned char* ws = a.ws;
    const bf16* P = (const bf16*)(ws + WS_P); const float* S = (const float*)(ws + WS_S); bf16* XB = (bf16*)(ws + WS_X);
    const f32x2* LB = (const f32x2*)(ws + WS_SMALL + 32 * 1024); const f32x2* LB64 = (const f32x2*)(ws + WS_SMALL + 64 * 1024); const f32x2* BBAR = (const f32x2*)(ws + WS_SMALL + 128 * 1024);
    for (int id = vcu * NTHR + tid; id < S5G * 16 * 64; id += G * NTHR) { const int p = id & 63, b = (id >> 6) & 15, g = id >> 10;
        const f32x2 lb = LB[g * 64 + p], l64 = LB64[g * 64 + p];
        float xr = 0.f, xi = 0.f;
        for (int s = 0; s < NMETA; ++s) { const bf16* up = P + (size_t)(META0 + s) * NIN + PU + g * 16; float br = 0.f, bi = 0.f;
#pragma unroll
            for (int hi = 0; hi < 16; ++hi) { const f32x2 bb = BBAR[((size_t)g * 64 + p) * 16 + hi]; const float u = bf2f(up[hi]); br += bb.x * u; bi += bb.y * u; }
            const float nr = lb.x * xr - lb.y * xi + br, ni = lb.x * xi + lb.y * xr + bi; xr = nr; xi = ni; }
        bf16* xo = XB + (((size_t)0 * S5G + g) * 16 + b) * 128; xo[p] = (bf16)f2bf(xr); xo[64 + p] = (bf16)f2bf(xi);
#pragma unroll 4
        for (int c = 0; c < 63; ++c) { const float* sp = S + (((size_t)c * S5G + g) * 16 + b) * 128; const float sr = sp[p], si = sp[64 + p];
            const float nr = l64.x * xr - l64.y * xi + sr, ni = l64.x * xi + l64.y * xr + si; xr = nr; xi = ni;
            bf16* xo2 = XB + (((size_t)(c + 1) * S5G + g) * 16 + b) * 128; xo2[p] = (bf16)f2bf(xr); xo2[64 + p] = (bf16)f2bf(xi); } }
}
__device__ __forceinline__ void s5c_phase(const Args& a, LAS unsigned char* lds, int vcu, int G, int tid, int wave, int lane) {
    unsigned char* ws = a.ws; const int fr = lane & 15, fq = lane >> 4;
    const bf16* P = (const bf16*)(ws + WS_P); const bf16* M2 = (const bf16*)(ws + WS_M2); const bf16* XB = (const bf16*)(ws + WS_X); const bf16* KTAB = (const bf16*)(ws + WS_KTAB);
    bf16* GO = (bf16*)(ws + WS_G);
    constexpr int KT_BYTES = 65 * 512, U_OFF = KT_BYTES, U_ROW = 2064;
    int gl = -1;
    for (int it = vcu; it < S5G * NCH; it += G) { const int g = it >> 6, c = it & 63;
        __syncthreads();
        if (g != gl) { gl = g;
            for (int i = tid; i < 65 * 32; i += NTHR) { const int e = i >> 5, q = i & 31; v4u v = (v4u){0u, 0u, 0u, 0u}; if (e > 0) v = *(const v4u*)(KTAB + ((size_t)g * 64 + (e - 1)) * 256 + q * 8); *(LAS v4u*)(lds + e * 512 + q * 16) = v; } }
        for (int i = tid; i < 16 * 64 * 2; i += NTHR) { const int hh = i & 1, s = (i >> 1) & 63, b = i >> 7;
            const v4u v = *(const v4u*)(P + ((size_t)b * SEQ + 64 * c + s) * NIN + PU + g * 16 + 8 * hh); *(LAS v4u*)(lds + U_OFF + b * U_ROW + s * 32 + hh * 16) = v; }
        __syncthreads();
        bf16x8 xf[4];
#pragma unroll
        for (int ks = 0; ks < 4; ++ks) xf[ks] = *(const bf16x8*)(XB + (((size_t)c * S5G + g) * 16 + fr) * 128 + 32 * ks + 8 * fq);
        for (int tt = 0; tt < 8; ++tt) { const int t = wave + 8 * tt;
            f32x4 acc = (f32x4){0.f, 0.f, 0.f, 0.f};
            const bf16* m2p = M2 + ((size_t)g * 1024 + t * 16 + fr) * 128 + 8 * fq;
#pragma unroll
            for (int ks = 0; ks < 4; ++ks) acc = __builtin_amdgcn_mfma_f32_16x16x32_bf16(*(const bf16x8*)(m2p + 32 * ks), xf[ks], acc, 0, 0, 0);
            const int nk = (t >> 1) + 1;
            const LAS unsigned char* ab = lds + (t + 1 - (fq >> 1)) * 512 + fr * 32 + (fq & 1) * 16;
            const LAS unsigned char* bb = lds + U_OFF + fr * U_ROW + (fq >> 1) * 32 + (fq & 1) * 16;
            for (int kk = 0; kk < nk; ++kk) { const bf16x8 af = *(const LAS bf16x8*)(ab - kk * 1024), bf = *(const LAS bf16x8*)(bb + kk * 64);
                acc = __builtin_amdgcn_mfma_f32_16x16x32_bf16(af, bf, acc, 0, 0, 0); }
            v2u o; o.x = pk2(gelu_tanh(acc[0]), gelu_tanh(acc[1])); o.y = pk2(gelu_tanh(acc[2]), gelu_tanh(acc[3]));
            *(v2u*)(GO + ((size_t)fr * SEQ + 64 * c + t) * S5W + g * 16 + 4 * fq) = o; }
    }
}

typedef short s16x4 __attribute__((ext_vector_type(4)));
__device__ __forceinline__ s16x4 trr(const LAS unsigned char* p) { return __builtin_bit_cast(s16x4, __builtin_amdgcn_ds_read_tr16_b64_v4i16((LAS s16x4*)p)); }
constexpr int QS = 272, VST = 544, SS = 144;
constexpr int ML_GATE = 0, ML_CW = 7424  , ML_SP = ML_CW + 5120, ML_Q = ML_SP + 64 * SS, ML_K = ML_Q + 64 * QS, ML_V = ML_K + 64 * QS, ML_TOP = ML_V + 64 * VST;
constexpr int ML_A = ML_GATE, ML_MS = ML_GATE + 256, ML_WI = ML_GATE + 512, ML_EM = ML_GATE + 768, ML_WK = ML_GATE + 1024, ML_QN = ML_GATE + 1280, ML_RS = ML_GATE + 1536  ,
              ML_NV = ML_GATE + 2560  , ML_SC = ML_GATE + 3072  , ML_HS = ML_GATE + 3136  , ML_END = ML_HS + 4096;
static_assert(ML_END <= ML_CW && ML_TOP <= LDS_BYTES - 256, "mlstm lds");
constexpr size_t WS_ST = 980 * MiB;
constexpr size_t WS_NST = 1004 * MiB;
constexpr size_t WS_END2 = 1005 * MiB;

template <bool FULL>
__device__ __forceinline__ void mlstm_item(const Args& a, LAS unsigned char* lds, int b, int h, int seg, int tid, int wave, int lane) {
    unsigned char* ws = a.ws;
    const bf16* P = (const bf16*)(ws + WS_P); const float* IFG = (const float*)(ws + WS_IF);
    bf16* A2 = (bf16*)a.out;
    const float* ng = a.in[17];
    float* ST = (float*)(ws + WS_ST); float* NST = (float*)(ws + WS_NST); float* MST = (float*)(ws + WS_NST + 128 * 1024);
    LAS float* gA = (LAS float*)(lds + ML_A); LAS float* gMS = (LAS float*)(lds + ML_MS); LAS float* gWI = (LAS float*)(lds + ML_WI); LAS float* gEM = (LAS float*)(lds + ML_EM);
    LAS float* gWK = (LAS float*)(lds + ML_WK); LAS float* gQN = (LAS float*)(lds + ML_QN); LAS float* gRS = (LAS float*)(lds + ML_RS); LAS float* gNV = (LAS float*)(lds + ML_NV);
    LAS float* gSC = (LAS float*)(lds + ML_SC); LAS float* gHS = (LAS float*)(lds + ML_HS); LAS float* gCW = (LAS float*)(lds + ML_CW);
    const int c0 = seg ? 16 * seg + 1 : 0, c1 = 16 * seg + 17;
    const int chain = b * MH + h;
    f32x4 accC[8][2];
    __syncthreads();
    for (int i = tid; i < 2 * 5 * 128; i += NTHR) { const int isk = i / 640, tap = (i / 128) % 5, ch = i & 127; const int gch = isk * 512 + h * DK + ch; gCW[i] = tap < 4 ? a.in[6][tap * 1024 + gch] : a.in[7][gch]; }
    float m_init = 0.f;
    if (FULL && seg > 0) {
        const float* s0 = ST + (size_t)(chain * 3) * 32768 + tid;
#pragma unroll
        for (int dt = 0; dt < 8; ++dt)
#pragma unroll
            for (int et = 0; et < 2; ++et)
#pragma unroll
                for (int r = 0; r < 4; ++r) accC[dt][et][r] = s0[(dt * 8 + et * 4 + r) * 512];
        float nv = tid < 128 ? NST[(size_t)(chain * 3) * 128 + tid] : 0.f;
        m_init = MST[(chain * 3) * 4];
        for (int s2 = 1; s2 < seg; ++s2) { const int it = chain * 3 + s2; const float ml = MST[it * 4], F = MST[it * 4 + 1];
            const float mn = fmaxf(F + m_init, ml), a1 = __expf(F + m_init - mn), a2 = __expf(ml - mn); const float* s1 = ST + (size_t)it * 32768 + tid;
#pragma unroll
            for (int dt = 0; dt < 8; ++dt)
#pragma unroll
                for (int et = 0; et < 2; ++et)
#pragma unroll
                    for (int r = 0; r < 4; ++r) accC[dt][et][r] = a1 * accC[dt][et][r] + a2 * s1[(dt * 8 + et * 4 + r) * 512];
            if (tid < 128) nv = a1 * nv + a2 * NST[(size_t)it * 128 + tid];
            m_init = mn; }
        if (tid < 128) gNV[tid] = nv;
    } else {
#pragma unroll
        for (int i = 0; i < 8; ++i) { accC[i][0] = (f32x4){0.f, 0.f, 0.f, 0.f}; accC[i][1] = (f32x4){0.f, 0.f, 0.f, 0.f}; }
        if (tid < 128) gNV[tid] = 0.f;
    }
    if (tid == 0) { gSC[0] = m_init; gSC[3] = 0.f; }
    v4u rq[7], rv[4]; float gli = -INFINITY, glf = 0.f;
#define ML_ROW(sp) ((sp) < NMETA ? META0 + (sp) : b * SEQ + ((sp) - NMETA))
#define ML_ISSUE(c) do { \
        if (FULL || isk) { _Pragma("unroll") for (int w = 0; w < 7; ++w) { const int sp = 64 * (c) + 4 * rg - 3 + w - 48; rq[w] = (v4u){0u, 0u, 0u, 0u}; \
            if (sp >= 0) rq[w] = *(const v4u*)((const char*)P + ((unsigned)ML_ROW(sp) * (unsigned)(NIN * 2) + (unsigned)((PQ + isk * 512 + h * DK + 8 * cg) * 2))); } } \
        { const int sp = 64 * (c) + vj - 48; _Pragma("unroll") for (int i = 0; i < 4; ++i) { rv[i] = (v4u){0u, 0u, 0u, 0u}; if (sp >= 0) rv[i] = *(const v4u*)((const char*)P + ((unsigned)ML_ROW(sp) * (unsigned)(NIN * 2) + (unsigned)((PV + h * DV + 8 * (vp + 8 * i)) * 2))); } } \
        if (wave == 0) { const int sp = 64 * (c) + lv - 48; gli = -INFINITY; glf = 0.f; if (sp >= 0) { const float* ip = IFG + (size_t)ML_ROW(sp) * 8; gli = ip[h]; glf = ip[4 + h]; } } } while (0)
#define ML_WRITE(c) do { \
        if (FULL || isk) { f32x4 cwv[5][2]; _Pragma("unroll") for (int t = 0; t < 5; ++t) { cwv[t][0] = *(const LAS f32x4*)(gCW + (isk * 5 + t) * 128 + 8 * cg); cwv[t][1] = *(const LAS f32x4*)(gCW + (isk * 5 + t) * 128 + 8 * cg + 4); } \
            const float sc = isk ? 0.08838834764831845f : 1.f; \
            _Pragma("unroll") for (int i = 0; i < 4; ++i) { float o8[8]; _Pragma("unroll") for (int e = 0; e < 4; ++e) { o8[e] = cwv[4][0][e]; o8[4 + e] = cwv[4][1][e]; } \
                _Pragma("unroll") for (int w = 0; w < 4; ++w) { const v4u x = rq[i + w]; \
                    o8[0] += cwv[w][0][0] * bflo(x.x); o8[1] += cwv[w][0][1] * bfhi(x.x); o8[2] += cwv[w][0][2] * bflo(x.y); o8[3] += cwv[w][0][3] * bfhi(x.y); \
                    o8[4] += cwv[w][1][0] * bflo(x.z); o8[5] += cwv[w][1][1] * bfhi(x.z); o8[6] += cwv[w][1][2] * bflo(x.w); o8[7] += cwv[w][1][3] * bfhi(x.w); } \
                const bool ok = 64 * (c) + 4 * rg + i - 48 >= 0; \
                _Pragma("unroll") for (int e = 0; e < 8; ++e) o8[e] = ok ? o8[e] * sigmf(o8[e]) * sc : 0.f; \
                *(LAS v4u*)(lds + (isk ? ML_K : ML_Q) + (4 * rg + i) * QS + cg * 16) = (v4u){pk2(o8[0], o8[1]), pk2(o8[2], o8[3]), pk2(o8[4], o8[5]), pk2(o8[6], o8[7])}; } } \
        _Pragma("unroll") for (int i = 0; i < 4; ++i) *(LAS v4u*)(lds + ML_V + vj * VST + (vp + 8 * i) * 16) = rv[i]; \
        if (wave == 0) { const float li = gli, lf = (64 * (c) + lv - 48 >= 0) ? log_sigmoid(glf) : 0.f; \
            float bc = lf; _Pragma("unroll") for (int o = 1; o < 64; o <<= 1) { const float t = __shfl_up(bc, o); if (lv >= o) bc += t; } \
            const float av = li - bc; float pm = av; _Pragma("unroll") for (int o = 1; o < 64; o <<= 1) { const float t = __shfl_up(pm, o); if (lv >= o) pm = fmaxf(pm, t); } \
            const float mprev = gSC[0]; const float Ms = fmaxf(mprev, pm); const float M63 = __shfl(Ms, 63), bl = __shfl(bc, 63); \
            gA[lv] = av; gMS[lv] = Ms; gWI[lv] = __expf(mprev - Ms); gEM[lv] = __expf(-(bc + Ms)); gWK[lv] = __expf(av - M63); \
            if (lv == 0) { gSC[1] = bl + M63; gSC[2] = __expf(mprev - M63); gSC[3] += bl; } } } while (0)
    __syncthreads();
    for (int c = c0 - 1; c < c1; ++c) {
        int lv = lane, tv = tid; asm volatile("" : "+v"(lv), "+v"(tv));
        const int fr = lv & 15, fq = lv >> 4;
        const LAS unsigned char* qfrag = lds + ML_Q + fr * QS + fq * 16;
        const LAS unsigned char* kfrag = lds + ML_K + fr * QS + fq * 16;
        const LAS unsigned char* qperm = lds + ML_Q + fr * QS + fq * 8;
        const LAS unsigned char* spfrag = lds + ML_SP + fr * SS + fq * 16;
        const int tq = (lv & 15) >> 2, tp = lv & 3;
        const LAS unsigned char* vtr = lds + ML_V + (8 * fq + tq) * VST + (32 * wave + 4 * tp) * 2;
        const LAS unsigned char* ktr = lds + ML_K + (8 * fq + tq) * QS + (4 * tp) * 2;
        const int isk = tv >> 8, rg = (tv >> 4) & 15, cg = tv & 15; const int vj = tv >> 3, vp = tv & 7;
        if (c + 1 < c1) ML_ISSUE(c + 1);
        if (c >= c0) {
        if (FULL && c > 0) {
#pragma unroll
            for (int i2 = 0; i2 < 2; ++i2) { const int tile = 2 * wave + i2, jt = tile >> 2, st = tile & 3;
                f32x4 acc = (f32x4){0.f, 0.f, 0.f, 0.f};
                if (jt <= st) {
#pragma unroll
                    for (int ks = 0; ks < 4; ++ks) { const bf16x8 af = *(const LAS bf16x8*)(kfrag + jt * 16 * QS + ks * 64), bf = *(const LAS bf16x8*)(qfrag + st * 16 * QS + ks * 64);
                        acc = __builtin_amdgcn_mfma_f32_16x16x32_bf16(af, bf, acc, 0, 0, 0); } }
                const int s = 16 * st + fr, j0 = 16 * jt + 4 * fq; const float Ms = gMS[s]; float rs = 0.f; float sv[4];
#pragma unroll
                for (int r = 0; r < 4; ++r) { const int j = j0 + r; const float w = (j <= s) ? __expf(gA[j] - Ms) : 0.f; sv[r] = acc[r] * w; rs += sv[r]; }
                rs += __shfl_xor(rs, 16); rs += __shfl_xor(rs, 32);
                if (fq == 0) gRS[s * 4 + jt] = rs;
                *(LAS v2u*)(lds + ML_SP + s * SS + j0 * 2) = (v2u){pk2(sv[0], sv[1]), pk2(sv[2], sv[3])}; }
            { const int s = 8 * wave + (lv >> 3), ds = lv & 7; float q = 0.f;
#pragma unroll
              for (int hh = 0; hh < 2; ++hh) { const v4u x = *(const LAS v4u*)(lds + ML_Q + s * QS + (2 * ds + hh) * 16); const LAS float* nv = gNV + 16 * ds + 8 * hh;
                  q += bflo(x.x) * nv[0] + bfhi(x.x) * nv[1] + bflo(x.y) * nv[2] + bfhi(x.y) * nv[3] + bflo(x.z) * nv[4] + bfhi(x.z) * nv[5] + bflo(x.w) * nv[6] + bfhi(x.w) * nv[7]; }
              q += __shfl_xor(q, 1); q += __shfl_xor(q, 2); q += __shfl_xor(q, 4);
              if (ds == 0) gQN[s] = q; }
            __syncthreads();
            f32x4 accN[2][4];
#pragma unroll
            for (int et = 0; et < 2; ++et)
#pragma unroll
                for (int st = 0; st < 4; ++st) accN[et][st] = (f32x4){0.f, 0.f, 0.f, 0.f};
#pragma unroll
            for (int ks = 0; ks < 4; ++ks) { bf16x8 af[2], bf[4];
#pragma unroll
                for (int et = 0; et < 2; ++et) { const f32x4 lo = accC[2 * ks][et], hi4 = accC[2 * ks + 1][et];
                    const v4u w = (v4u){pk2(lo[0], lo[1]), pk2(lo[2], lo[3]), pk2(hi4[0], hi4[1]), pk2(hi4[2], hi4[3])}; af[et] = __builtin_bit_cast(bf16x8, w); }
#pragma unroll
                for (int st = 0; st < 4; ++st) { const v2u l2 = *(const LAS v2u*)(qperm + st * 16 * QS + ks * 64), h2 = *(const LAS v2u*)(qperm + st * 16 * QS + ks * 64 + 32);
                    const v4u w = (v4u){l2.x, l2.y, h2.x, h2.y}; bf[st] = __builtin_bit_cast(bf16x8, w); }
#pragma unroll
                for (int et = 0; et < 2; ++et)
#pragma unroll
                    for (int st = 0; st < 4; ++st) accN[et][st] = __builtin_amdgcn_mfma_f32_16x16x32_bf16(af[et], bf[st], accN[et][st], 0, 0, 0); }
            float dn[4];
#pragma unroll
            for (int st = 0; st < 4; ++st) { const int s = 16 * st + fr; const float wi = gWI[s];
                accN[0][st] = accN[0][st] * wi; accN[1][st] = accN[1][st] * wi;
                const f32x4 rs4 = *(const LAS f32x4*)(gRS + s * 4); const float den = (rs4[0] + rs4[1]) + (rs4[2] + rs4[3]) + wi * gQN[s];
                dn[st] = __builtin_amdgcn_rcpf(fmaxf(fabsf(den), gEM[s])); }
#pragma unroll
            for (int ks = 0; ks < 2; ++ks) { bf16x8 bf[4], vf[2];
#pragma unroll
                for (int et = 0; et < 2; ++et) { const s16x4 lo = trr(vtr + ks * 32 * VST + et * 32), hi4 = trr(vtr + ks * 32 * VST + 4 * VST + et * 32);
                    vf[et] = (bf16x8){lo[0], lo[1], lo[2], lo[3], hi4[0], hi4[1], hi4[2], hi4[3]}; }
#pragma unroll
                for (int st = 0; st < 4; ++st) bf[st] = *(const LAS bf16x8*)(spfrag + st * 16 * SS + ks * 64);
#pragma unroll
                for (int et = 0; et < 2; ++et)
#pragma unroll
                    for (int st = 0; st < 4; ++st) accN[et][st] = __builtin_amdgcn_mfma_f32_16x16x32_bf16(vf[et], bf[st], accN[et][st], 0, 0, 0); }
#pragma unroll
            for (int st = 0; st < 4; ++st) { float s1 = 0.f, s2 = 0.f;
#pragma unroll
                for (int et = 0; et < 2; ++et) { accN[et][st] = accN[et][st] * dn[st];
#pragma unroll
                    for (int r = 0; r < 4; ++r) { const float v = accN[et][st][r]; s1 += v; s2 += v * v; } }
                s1 += __shfl_xor(s1, 16); s1 += __shfl_xor(s1, 32); s2 += __shfl_xor(s2, 16); s2 += __shfl_xor(s2, 32);
                if (fq == 0) *(LAS f32x2*)(gHS + ((16 * st + fr) * 8 + wave) * 2) = (f32x2){s1, s2}; }
            __syncthreads();
#pragma unroll
            for (int st = 0; st < 4; ++st) { const int s = 16 * st + fr; float s1 = 0.f, s2 = 0.f;
#pragma unroll
                for (int w2 = 0; w2 < 4; ++w2) { const f32x4 t = *(const LAS f32x4*)(gHS + (s * 8 + 2 * w2) * 2); s1 += t[0] + t[2]; s2 += t[1] + t[3]; }
                const float mean = s1 * (1.f / DV), var = fmaxf(s2 * (1.f / DV) - mean * mean, 0.f), rstd = 1.f / sqrtf(var + LN_EPS);
                const size_t row = (size_t)b * SEQ + 64 * (c - 1) + s;
#pragma unroll
                for (int et = 0; et < 2; ++et) { const int e0 = h * DV + 32 * wave + 16 * et + 4 * fq;
                    const v2u so = *(const v2u*)(P + row * NIN + PO + e0); const f32x4 gg = *(const f32x4*)(ng + e0); const f32x4 sof = pg8::bf4f(so.x, so.y);
                    const f32x4 o = (accN[et][st] - mean) * rstd * gg * sof;
                    *(v2u*)(A2 + row * D + e0) = (v2u){pk2(o[0], o[1]), pk2(o[2], o[3])}; } }
        }
        { const float decay = gSC[2];
#pragma unroll
          for (int dt = 0; dt < 8; ++dt) { accC[dt][0] = accC[dt][0] * decay; accC[dt][1] = accC[dt][1] * decay; }
#pragma unroll
          for (int ks = 0; ks < 2; ++ks) { const f32x4 w0 = *(const LAS f32x4*)(gWK + 32 * ks + 8 * fq), w1 = *(const LAS f32x4*)(gWK + 32 * ks + 8 * fq + 4);
              bf16x8 bw[2];
#pragma unroll
              for (int et = 0; et < 2; ++et) { const s16x4 lo = trr(vtr + ks * 32 * VST + et * 32), hi4 = trr(vtr + ks * 32 * VST + 4 * VST + et * 32);
                  const v4u x = __builtin_bit_cast(v4u, (bf16x8){lo[0], lo[1], lo[2], lo[3], hi4[0], hi4[1], hi4[2], hi4[3]});
                  const v4u y = (v4u){pk2(bflo(x.x) * w0[0], bfhi(x.x) * w0[1]), pk2(bflo(x.y) * w0[2], bfhi(x.y) * w0[3]), pk2(bflo(x.z) * w1[0], bfhi(x.z) * w1[1]), pk2(bflo(x.w) * w1[2], bfhi(x.w) * w1[3])};
                  bw[et] = __builtin_bit_cast(bf16x8, y); }
#pragma unroll
              for (int dt = 0; dt < 8; ++dt) { const s16x4 lo = trr(ktr + ks * 32 * QS + dt * 32), hi4 = trr(ktr + ks * 32 * QS + 4 * QS + dt * 32);
                  const bf16x8 af = (bf16x8){lo[0], lo[1], lo[2], lo[3], hi4[0], hi4[1], hi4[2], hi4[3]};
                  accC[dt][0] = __builtin_amdgcn_mfma_f32_16x16x32_bf16(af, bw[0], accC[dt][0], 0, 0, 0); accC[dt][1] = __builtin_amdgcn_mfma_f32_16x16x32_bf16(af, bw[1], accC[dt][1], 0, 0, 0); } }
          if (tv < 128) { float nn = gNV[tv] * decay; const LAS unsigned char* kp = lds + ML_K + tv * 2;
#pragma unroll 8
              for (int j = 0; j < 64; ++j) nn += gWK[j] * bf2f(*(const LAS bf16*)(kp + j * QS));
              gNV[tv] = nn; }
          if (tv == 0) gSC[0] = gSC[1]; }
        }
        __syncthreads();
        if (c + 1 < c1) ML_WRITE(c + 1);
        __syncthreads();
    }
#undef ML_ISSUE
#undef ML_WRITE
#undef ML_ROW
    if (!FULL) { const int it = chain * 3 + seg; float* so = ST + (size_t)it * 32768 + tid;
#pragma unroll
        for (int dt = 0; dt < 8; ++dt)
#pragma unroll
            for (int et = 0; et < 2; ++et)
#pragma unroll
                for (int r = 0; r < 4; ++r) so[(dt * 8 + et * 4 + r) * 512] = accC[dt][et][r];
        if (tid < 128) NST[(size_t)it * 128 + tid] = gNV[tid];
        if (tid == 0) { MST[it * 4] = gSC[0]; MST[it * 4 + 1] = gSC[3]; } }
}

template <bool OUT_BF16>
__device__ __forceinline__ void ln_rows(const float* V, const float* g, const float* bta, void* O, int vcu, int G, int wave, int lane) {
    const int gw = vcu * NWAVES + wave, NGW = G * NWAVES;
    f32x4 gg[4], bb[4];
#pragma unroll
    for (int j = 0; j < 4; ++j) { gg[j] = ((const f32x4*)g)[lane + 64 * j]; bb[j] = ((const f32x4*)bta)[lane + 64 * j]; }
    for (int m = gw; m < MR; m += NGW) { const f32x4* xr = (const f32x4*)(V + (size_t)m * D) + lane;
        f32x4 v[4]; float s = 0.f;
#pragma unroll
        for (int j = 0; j < 4; ++j) { v[j] = xr[64 * j]; s += (v[j].x + v[j].y) + (v[j].z + v[j].w); }
        const float mean = wave_sum(s) * (1.f / D); float s2 = 0.f;
#pragma unroll
        for (int j = 0; j < 4; ++j) { v[j] = v[j] - mean; s2 += (v[j].x * v[j].x + v[j].y * v[j].y) + (v[j].z * v[j].z + v[j].w * v[j].w); }
        const float rstd = 1.f / sqrtf(wave_sum(s2) * (1.f / D) + LN_EPS);
#pragma unroll
        for (int j = 0; j < 4; ++j) { const f32x4 y = v[j] * rstd * gg[j] + bb[j];
            if (OUT_BF16) ((unsigned long long*)((bf16*)O + (size_t)m * D))[lane + 64 * j] = (unsigned long long)pk2(y.x, y.y) | ((unsigned long long)pk2(y.z, y.w) << 32);
            else ((f32x4*)((float*)O + (size_t)m * D))[lane + 64 * j] = y; } }
}

#define GAS __attribute__((address_space(1)))
typedef GAS unsigned gu32;
typedef GAS unsigned long long gu64;
#define RLX_AGENT __ATOMIC_RELAXED, __HIP_MEMORY_SCOPE_AGENT
#define LDS_WAIT() asm volatile("s_waitcnt lgkmcnt(0)" ::: "memory")
#define VM_WAIT() asm volatile("s_waitcnt vmcnt(0)" ::: "memory")
__device__ __forceinline__ unsigned long long rt() { return __builtin_amdgcn_s_memrealtime(); }
#define XB_TMO      128
#define XB_XCNT(j)  (256  + 64 * (j))
#define XB_XSUB(j)  (1280 + 64 * (j))
#define XB_XGEN(j)  (2304 + 64 * (j))
#define XB_TOP      3328
#define XB_TOPGEN   3392
#define XCD_BAR_WORDS 3456
#define XB_SPIN_CAP (1u << 18)

__device__ __forceinline__ unsigned xb_ld(unsigned* p)              { return __hip_atomic_load(p, __ATOMIC_RELAXED, __HIP_MEMORY_SCOPE_AGENT); }
__device__ __forceinline__ unsigned xb_add(unsigned* p, unsigned v) { return __hip_atomic_fetch_add(p, v, __ATOMIC_RELAXED, __HIP_MEMORY_SCOPE_AGENT); }
__device__ __forceinline__ unsigned xb_xcc_id() { return (unsigned)__builtin_amdgcn_s_getreg((3 << 11) | 20) & 0xFu; }
#define XB_SPIN(cond, bar) do { unsigned _sp = 0; while (cond) { __builtin_amdgcn_s_sleep(1); \
    if ((++_sp & 255u) == 0u) { if (xb_ld(&(bar)[XB_TMO])) break; if (_sp > XB_SPIN_CAP) { atomicAdd(&(bar)[XB_TMO], 1u); break; } } } } while (0)

struct XcdBarrier {
    unsigned* bar; unsigned x;
    volatile LAS unsigned* st;
};

__device__ __forceinline__ XcdBarrier xcd_barrier_post(unsigned* bar, volatile LAS unsigned* st) {
    XcdBarrier b; b.bar = bar; b.x = xb_xcc_id(); b.st = st;
    if (threadIdx.x == 0) (void)xb_add(&bar[XB_XCNT(b.x)], 1u);
    return b;
}
__device__ __forceinline__ void xcd_barrier_complete(unsigned* bar, unsigned x, unsigned& nloc, unsigned& nx) {
    const unsigned G = gridDim.x * gridDim.y * gridDim.z;
    unsigned sum, cnt, mine, sp = 0u;
    for (;;) {
        sum = 0u; cnt = 0u; mine = 0u;
#pragma unroll
        for (unsigned j = 0; j < 16; ++j) { const unsigned c = xb_ld(&bar[XB_XCNT(j)]); sum += c; cnt += (c > 0u) ? 1u : 0u; mine = (j == x) ? c : mine; }
        if (sum == G) break;
        __builtin_amdgcn_s_sleep(1);
        if ((++sp & 255u) == 0u) { if (xb_ld(&bar[XB_TMO])) break; if (sp > XB_SPIN_CAP) { atomicAdd(&bar[XB_TMO], 1u); break; } }
    }
    nloc = mine > 0u ? mine : 1u; nx = cnt > 0u ? cnt : 1u;
}

__device__ __forceinline__ void xcd_barrier(const XcdBarrier& b) {
    asm volatile("s_waitcnt vmcnt(0)" ::: "memory");
    __syncthreads();
    if (threadIdx.x == 0) {
        unsigned* bar = b.bar;
        __builtin_amdgcn_s_waitcnt(0);
        unsigned nloc = b.st[0], nx = b.st[1];
        if (nloc == 0u) { xcd_barrier_complete(bar, b.x, nloc, nx); b.st[0] = nloc; b.st[1] = nx; }
        const unsigned old = xb_add(&bar[XB_XSUB(b.x)], 1u);
        const unsigned gen = old / nloc;
        if (old + 1u == (gen + 1u) * nloc) {
            __builtin_amdgcn_fence(__ATOMIC_RELEASE, "agent");
            asm volatile("s_waitcnt vmcnt(0)" ::: "memory");
            const unsigned og = xb_add(&bar[XB_TOP], 1u);
            const unsigned tg = og / nx;
            if (og + 1u == (tg + 1u) * nx) xb_add(&bar[XB_TOPGEN], 1u);
            else XB_SPIN(xb_ld(&bar[XB_TOPGEN]) == tg, bar);
            __builtin_amdgcn_fence(__ATOMIC_ACQUIRE, "agent");
            xb_add(&bar[XB_XGEN(b.x)], 1u);
            asm volatile("s_waitcnt vmcnt(0)" ::: "memory");
        } else {
            XB_SPIN(xb_ld(&bar[XB_XGEN(b.x)]) == gen, bar);
            __builtin_amdgcn_fence(__ATOMIC_ACQUIRE, "agent");
            asm volatile("s_waitcnt vmcnt(0)" ::: "memory");
        }
    }
    __syncthreads();
}

constexpr int CW_BAR = 4096;
constexpr int NPHASE = 14;
__global__ void __launch_bounds__(NTHR, 2) fwd_kernel(Args args) {
    extern __shared__ __attribute__((aligned(16))) unsigned char lds_raw[];
    LAS unsigned char* lds = (LAS unsigned char*)lds_raw;
    const int tid = threadIdx.x, lane = tid & 63, wave = __builtin_amdgcn_readfirstlane(tid >> 6);
    const int G = gridDim.x; const int bx = blockIdx.x; const int vcu = (G % 8 == 0) ? (bx % 8) * (G / 8) + bx / 8 : bx;
    unsigned char* ws = args.ws;
    const int lo = args.ph_lo, hi = args.ph_hi;
#define IN(k) (lo <= (k) && (k) < hi)
#define SEAM(k) do { if (IN(k) && IN((k) + 1)) xcd_barrier(bar); } while (0)
    volatile LAS unsigned* MISC = (volatile LAS unsigned*)(lds + LDS_BYTES - 128);
    if (tid < 32) MISC[tid] = 0u;
    __syncthreads();
    XcdBarrier bar; bar.bar = (unsigned*)(ws + WS_CTL) + CW_BAR; bar.x = 0; bar.st = nullptr;
    if (hi - lo > 1) bar = xcd_barrier_post((unsigned*)(ws + WS_CTL) + CW_BAR, MISC + 8);
    if (IN(0)) p0_prologue(args, lds, vcu, G, wave, lane);
    SEAM(0);
    if (IN(1)) { pg8::Gemm g{(const bf16*)(ws + WS_H0), (const bf16*)(ws + WS_WIN), MT, NIN, D}; pg8::StaticOrder S; S.init(MT, NIN, G, bx);
        pg8::EpiIn E{(bf16*)(ws + WS_P), NIN, (const float*)(ws + WS_SMALL), 10};
        pg8::gemm_phase<pg8::EpiIn, pg8::StaticOrder, true, true>(lds, g, S, E); }
    SEAM(1);
    if (IN(2)) s5a_phase(args, vcu, G, wave, lane);
    SEAM(2);
    if (IN(3)) s5b_phase(args, vcu, G, tid);
    SEAM(3);
    if (IN(4)) s5c_phase(args, lds, vcu, G, tid, wave, lane);
    SEAM(4);
    if (IN(5)) { for (int it = vcu; it < BATCH * MH * 3; it += G) mlstm_item<false>(args, lds, (it / 3) >> 2, (it / 3) & 3, it % 3, tid, wave, lane); }
    SEAM(5);
    if (IN(6)) { for (int it = vcu; it < BATCH * MH * 4; it += G) mlstm_item<true>(args, lds, (it >> 2) >> 2, (it >> 2) & 3, it & 3, tid, wave, lane); }
    SEAM(6);
    if (IN(7)) { pg8::Gemm g{(const bf16*)(ws + WS_G), (const bf16*)(ws + WS_WGLU), MR, 2 * D, S5W}; pg8::StaticOrder S; S.init(MR, 2 * D, G, bx);
        pg8::EpiGlu E{(const bf16*)(ws + WS_P) + PGS, NIN, (bf16*)args.out + (size_t)MR * D, D};
        pg8::gemm_phase<pg8::EpiGlu, pg8::StaticOrder, true, true>(lds, g, S, E); }
    SEAM(7);
    if (IN(8)) { pg8::Gemm g{(const bf16*)args.out, (const bf16*)(ws + WS_WMO), MR, D, D}; pg8::StaticOrder S; S.init(MR, D, G, bx);
        pg8::EpiMo E{(const bf16*)(ws + WS_P) + PGM, NIN, (bf16*)args.out + (size_t)MR * D, D};
        pg8::gemm_phase<pg8::EpiMo, pg8::StaticOrder, true, true>(lds, g, S, E); }
    SEAM(8);
    if (IN(9)) { pg8::Gemm g{(const bf16*)args.out + (size_t)MR * D, (const bf16*)(ws + WS_WO), MR, D, D}; pg8::StaticOrder S; S.init(MR, D, G, bx);
        pg8::EpiRes E{(const bf16*)(ws + WS_H0), (float*)(ws + WS_V1), D, ALPHA};
        pg8::gemm_phase<pg8::EpiRes, pg8::StaticOrder, true, true>(lds, g, S, E); }
    SEAM(9);
    if (IN(10)) ln_rows<true>((const float*)(ws + WS_V1), args.in[20], args.in[21], (void*)(ws + WS_H1), vcu, G, wave, lane);
    SEAM(10);
    if (IN(11)) { pg8::Gemm g{(const bf16*)(ws + WS_H1), (const bf16*)(ws + WS_WUP), MR, FF, D}; pg8::StaticOrder S; S.init(MR, FF, G, bx);
        pg8::EpiUp E{(bf16*)(ws + WS_HFF), FF, args.in[23]};
        pg8::gemm_phase<pg8::EpiUp, pg8::StaticOrder, true, true>(lds, g, S, E); }
    SEAM(11);
    if (IN(12)) { pg8::Gemm g{(const bf16*)(ws + WS_HFF), (const bf16*)(ws + WS_WDN), MR, D, FF}; pg8::StaticOrder S; S.init(MR, D, FF == 0 ? G : G, bx);
        pg8::EpiRes E{(const bf16*)(ws + WS_H1), args.out, D, ALPHA};
        pg8::gemm_phase<pg8::EpiRes, pg8::StaticOrder, true, true>(lds, g, S, E); }
    SEAM(12);
    if (IN(13)) ln_rows<false>(args.out, args.in[25], args.in[26], (void*)args.out, vcu, G, wave, lane);
#undef SEAM
#undef IN
}

extern "C" void kernel_launch(void* const* d_in, const int* in_sizes, int n_in, void* d_out, int out_size, void* d_ws, size_t ws_size, hipStream_t stream) {
    static int grid = 0;
    if (grid == 0) {
        if (n_in != 27 || in_sizes[0] != MR * D || out_size != MR * D || ws_size < WS_END2) { fprintf(stderr, "kernel_launch: unexpected shapes (n_in %d, in0 %d, out %d, ws %zu); nothing launched\n", n_in, n_in > 0 ? in_sizes[0] : -1, out_size, ws_size); grid = -1; return; }
        int dev = 0, cus = 0;
        if (hipGetDevice(&dev) != hipSuccess || hipDeviceGetAttribute(&cus, hipDeviceAttributeMultiprocessorCount, dev) != hipSuccess) { grid = -1; return; }
        if (hipFuncSetAttribute((const void*)fwd_kernel, hipFuncAttributeMaxDynamicSharedMemorySize, LDS_BYTES) != hipSuccess) { fprintf(stderr, "kernel_launch: hipFuncSetAttribute failed\n"); grid = -1; return; }
        (void)hipGetLastError();
        grid = cus;
    }
    if (grid < 0) return;
    Args a{};
    for (int i = 0; i < 27; ++i) a.in[i] = (const float*)d_in[i];
    a.out = (float*)d_out; a.ws = (unsigned char*)d_ws;
#if defined(PROBE_REP_MASK)
    for (int ph = 0; ph < NPHASE; ++ph) { a.ph_lo = ph; a.ph_hi = ph + 1;
        for (int rep = 0; rep < (((PROBE_REP_MASK) >> ph) & 1 ? 2 : 1); ++rep) hipLaunchKernelGGL(fwd_kernel, dim3(grid), dim3(NTHR), LDS_BYTES, stream, a); }
#else
    if (hipMemsetAsync((char*)d_ws + WS_CTL, 0, CTL_ZERO_BYTES, stream) != hipSuccess) { fprintf(stderr, "kernel_launch: hipMemsetAsync failed\n"); return; }
    a.ph_lo = 0; a.ph_hi = NPHASE;
    hipLaunchKernelGGL(fwd_kernel, dim3(grid), dim3(NTHR), LDS_BYTES, stream, a);
#endif
}
```
